# Optimizing an MI355X kernel written in HIP

```python
import jax, jax.numpy as jnp
from jax import lax
import numpy as np

D_MODEL = 1024
BATCH = 2
SEQ = 8192
DEPTH = 4
DEC_BATCH = 8
DEC_SEQ = 2048
PAST_LEN = 128

N_HEADS_A = 8
QK_NOPE = 64
QK_ROPE = 32
QK_DIM = QK_NOPE + QK_ROPE
V_DIM = 64
Q_LORA = 384
KV_LORA = 256
ROPE_BASE = 10000.0
Q_BLOCK = 128
CHUNK = 128
SGU_GROUPS = 8
GMLP_HALF = D_MODEL
SGU_CH = GMLP_HALF // SGU_GROUPS
D_FF = -(-8 * D_MODEL // (3 * 256)) * 256
IN_SPLITS = (Q_LORA, KV_LORA, QK_ROPE, GMLP_HALF, GMLP_HALF, D_MODEL, D_MODEL)
IN_COLS = sum(IN_SPLITS)
IN_OFFSETS = tuple(int(o) for o in np.cumsum(IN_SPLITS)[:-1])
N_MOD = 6
EPS = 1e-6

kernel_name = "hybrid_mla_sgu_adaln_encoder"


def rms_norm(x, g):
    x32 = x.astype(jnp.float32)
    y = x32 * lax.rsqrt(jnp.mean(x32 * x32, axis=-1, keepdims=True) + EPS)
    return y.astype(x.dtype) * g


def rope_tables(seq_len, dtype):
    pos = jnp.arange(seq_len, dtype=jnp.float32)
    inv = ROPE_BASE ** (-jnp.arange(0, QK_ROPE, 2, dtype=jnp.float32) / QK_ROPE)
    ang = pos[:, None] * inv[None, :]
    return jnp.cos(ang).astype(dtype), jnp.sin(ang).astype(dtype)


def apply_rope(x, cos, sin):
    x1, x2 = jnp.split(x, 2, axis=-1)
    c = cos[None, :, None, :]
    s = sin[None, :, None, :]
    return jnp.concatenate([x1 * c - x2 * s, x2 * c + x1 * s], axis=-1)


def mla_branch(q_lat, kv_lat, k_rope_raw, p, cos, sin):
    B, S, _ = q_lat.shape
    q = (rms_norm(q_lat, p["q_a_norm_g"]) @ p["w_q_b"]).reshape(B, S, N_HEADS_A, QK_DIM)
    kv = (rms_norm(kv_lat, p["kv_a_norm_g"]) @ p["w_kv_b"]).reshape(B, S, N_HEADS_A, QK_NOPE + V_DIM)
    k_nope, v = kv[..., :QK_NOPE], kv[..., QK_NOPE:]
    k_rope = jnp.broadcast_to(k_rope_raw[:, :, None, :], (B, S, N_HEADS_A, QK_ROPE))
    k = jnp.concatenate([k_nope, k_rope], axis=-1)
    q = rms_norm(q, p["q_norm_g"])
    k = rms_norm(k, p["k_norm_g"])
    q = jnp.concatenate([q[..., :QK_NOPE], apply_rope(q[..., QK_NOPE:], cos, sin)], axis=-1)
    k = jnp.concatenate([k[..., :QK_NOPE], apply_rope(k[..., QK_NOPE:], cos, sin)], axis=-1)
    nb = S // Q_BLOCK
    qb = q.reshape(B, nb, Q_BLOCK, N_HEADS_A, QK_DIM).transpose(1, 0, 2, 3, 4)
    scale = QK_DIM ** -0.5

    def attend(q_blk):
        s = jnp.einsum('bqhd,bkhd->bhqk', q_blk, k).astype(jnp.float32) * scale
        pr = jax.nn.softmax(s, axis=-1).astype(v.dtype)
        return jnp.einsum('bhqk,bkhd->bqhd', pr, v)

    o = lax.map(attend, qb)
    o = o.transpose(1, 0, 2, 3, 4).reshape(B, S, N_HEADS_A * V_DIM)
    return o @ p["w_o_a"]


def sgu_branch(zu, zv, p):
    B, S, _ = zu.shape
    u = jax.nn.gelu(zu)
    v = rms_norm(jax.nn.gelu(zv), p["sgu_norm_g"])
    v5 = v.reshape(B, S // CHUNK, CHUNK, SGU_GROUPS, SGU_CH)
    mixed = jnp.einsum('gpq,bnqgc->bnpgc', p["w_s"], v5) + p["b_s"].T[None, None, :, :, None]
    return (u * mixed.reshape(B, S, GMLP_HALF)) @ p["w_o_b"]


def encoder_layer(x, c, p, cos, sin):
    mod = jax.nn.silu(c) @ p["w_ada"] + p["b_ada"]
    sh1, sc1, g1, sh2, sc2, g2 = [m[:, None, :] for m in jnp.split(mod, N_MOD, axis=-1)]
    h = rms_norm(x, p["norm1_g"]) * (1 + sc1) + sh1
    proj = h @ p["w_in"]
    q_lat, kv_lat, k_rope, zu, zv, ga, gb = jnp.split(proj, IN_OFFSETS, axis=-1)
    out_a = mla_branch(q_lat, kv_lat, k_rope, p, cos, sin)
    out_b = sgu_branch(zu, zv, p)
    merged = jax.nn.sigmoid(ga) * out_a + jax.nn.sigmoid(gb) * out_b
    x = x + g1 * (merged @ p["w_out"])
    h2 = rms_norm(x, p["norm2_g"]) * (1 + sc2) + sh2
    up, gate = jnp.split(h2 @ p["w_ffn_in"], 2, axis=-1)
    x = x + g2 * ((jax.nn.silu(gate) * up) @ p["w_ffn_out"])
    return x


def setup_inputs(seed: int = 0) -> dict:
    key = jax.random.key(seed)
    ks = jax.random.split(key, 24)
    f32 = jnp.float32

    def nrm(k, shape, s):
        return jax.random.normal(k, shape, f32) * s

    def gain(k, shape):
        return 1.0 + 0.05 * jax.random.normal(k, shape, f32)

    L = DEPTH
    return {
        "x_prompt": nrm(ks[0], (BATCH, SEQ, D_MODEL), 1.0),
        "x_sample": nrm(ks[1], (DEC_BATCH, DEC_SEQ, D_MODEL), 1.0),
        "c_prompt": nrm(ks[2], (BATCH, D_MODEL), 1.0),
        "c_sample": nrm(ks[3], (DEC_BATCH, D_MODEL), 1.0),
        "w_ada": nrm(ks[4], (L, D_MODEL, N_MOD * D_MODEL), 0.5 * D_MODEL ** -0.5),
        "b_ada": nrm(ks[5], (L, N_MOD * D_MODEL), 0.02),
        "norm1_g": gain(ks[6], (L, D_MODEL)),
        "w_in": nrm(ks[7], (L, D_MODEL, IN_COLS), D_MODEL ** -0.5),
        "q_a_norm_g": gain(ks[8], (L, Q_LORA)),
        "kv_a_norm_g": gain(ks[9], (L, KV_LORA)),
        "w_q_b": nrm(ks[10], (L, Q_LORA, N_HEADS_A * QK_DIM), Q_LORA ** -0.5),
        "w_kv_b": nrm(ks[11], (L, KV_LORA, N_HEADS_A * (QK_NOPE + V_DIM)), KV_LORA ** -0.5),
        "q_norm_g": gain(ks[12], (L, QK_DIM)),
        "k_norm_g": gain(ks[13], (L, QK_DIM)),
        "w_o_a": nrm(ks[14], (L, N_HEADS_A * V_DIM, D_MODEL), (N_HEADS_A * V_DIM) ** -0.5),
        "sgu_norm_g": gain(ks[15], (L, GMLP_HALF)),
        "w_s": nrm(ks[16], (L, SGU_GROUPS, CHUNK, CHUNK), CHUNK ** -0.5),
        "b_s": 1.0 + nrm(ks[17], (L, SGU_GROUPS, CHUNK), 0.1),
        "w_o_b": nrm(ks[18], (L, GMLP_HALF, D_MODEL), GMLP_HALF ** -0.5),
        "w_out": nrm(ks[19], (L, D_MODEL, D_MODEL), D_MODEL ** -0.5),
        "norm2_g": gain(ks[20], (L, D_MODEL)),
        "w_ffn_in": nrm(ks[21], (L, D_MODEL, 2 * D_FF), D_MODEL ** -0.5),
        "w_ffn_out": nrm(ks[22], (L, D_FF, D_MODEL), D_FF ** -0.5),
    }


def reference(x_prompt, x_sample, c_prompt, c_sample, w_ada, b_ada, norm1_g, w_in,
              q_a_norm_g, kv_a_norm_g, w_q_b, w_kv_b, q_norm_g, k_norm_g, w_o_a,
              sgu_norm_g, w_s, b_s, w_o_b, w_out, norm2_g, w_ffn_in, w_ffn_out):
    cos_p, sin_p = rope_tables(x_prompt.shape[1], x_prompt.dtype)
    cos_s, sin_s = rope_tables(x_sample.shape[1], x_sample.dtype)
    y_prompt, y_sample = x_prompt, x_sample
    for l in range(DEPTH):
        p = {
            "w_ada": w_ada[l], "b_ada": b_ada[l], "norm1_g": norm1_g[l], "w_in": w_in[l],
            "q_a_norm_g": q_a_norm_g[l], "kv_a_norm_g": kv_a_norm_g[l],
            "w_q_b": w_q_b[l], "w_kv_b": w_kv_b[l], "q_norm_g": q_norm_g[l], "k_norm_g": k_norm_g[l],
            "w_o_a": w_o_a[l], "sgu_norm_g": sgu_norm_g[l], "w_s": w_s[l], "b_s": b_s[l],
            "w_o_b": w_o_b[l], "w_out": w_out[l], "norm2_g": norm2_g[l],
            "w_ffn_in": w_ffn_in[l], "w_ffn_out": w_ffn_out[l],
        }
        y_prompt = encoder_layer(y_prompt, c_prompt, p, cos_p, sin_p)
        y_sample = encoder_layer(y_sample, c_sample, p, cos_s, sin_s)
    return (y_prompt, y_sample)
```

```cpp
#include <hip/hip_runtime.h>
#include <cstdio>
#include <cstdint>
namespace pg8 {
#define PG8_LAS __attribute__((address_space(3)))
typedef unsigned short bf16_t;
typedef _Float16 bf16x8 __attribute__((ext_vector_type(8)));
typedef float f32x4 __attribute__((ext_vector_type(4)));
typedef unsigned u32x4 __attribute__((ext_vector_type(4)));
constexpr int BM = 256, BK = 64, HALF = 128, HTB = HALF * BK * 2  , STAGE_BYTES = 8 * HTB, NXCD = 8, WGM = 8;

__host__ __device__ __forceinline__ int lds_byte(int r, int c) { const int st = (r >> 4) * 2 + (c >> 5), rr = r & 15, cc = c & 31, ob = rr * 64 + cc * 2; return st * 1024 + (ob ^ (((ob >> 9) & 1) << 5)); }
__host__ __device__ __forceinline__ void stage_rc(int b, int& R, int& C) { const int st = b / 1024, sb = b % 1024, swz = sb ^ (((sb >> 9) & 1) << 5); R = (st >> 1) * 16 + swz / 64; C = (st & 1) * 32 + (swz % 64) / 2; }
__host__ __device__ __forceinline__ int perm32(int rho) { const int n = rho >> 4, i = rho & 15; return 8 * (i >> 2) + 4 * n + (i & 3); }

struct Unit { int pm, pn, idx; };
struct Gemm { const bf16_t* A; const bf16_t* Bt; int M, N, K, lda, ldb; };

struct StaticOrder {
    int nM, nN, nwg, G, c, i0 = 0, i1 = 1 << 20;
    __host__ __device__ void init(int M, int N, int G_, int c_) { nM = M / BM; nN = N / BM; nwg = nM * nN; G = G_; c = c_; }
    __host__ __device__ bool next(int i, Unit& u) const {
        if (i + i0 >= i1) return false;
        const long L = (long)(i + i0) * G + c; if (L >= nwg) return false;
        int wgid = (int)L; { const int q = nwg / NXCD, r = nwg % NXCD, xcd = wgid % NXCD, off = wgid / NXCD; wgid = (xcd < r ? xcd * (q + 1) : r * (q + 1) + (xcd - r) * q) + off; }
        const int nig = WGM * nN, gid = wgid / nig, fm = gid * WGM, gsz = (nM - fm) < WGM ? (nM - fm) : WGM;
        u.pm = fm + ((wgid % nig) % gsz); u.pn = (wgid % nig) / gsz; u.idx = i; return true;
    }
    __device__ __forceinline__ void a_ready(const Unit&) const {}
    __device__ __forceinline__ void done(const Unit&) const {}
};

__device__ __forceinline__ unsigned cvt_pk_bf16(float lo, float hi) { unsigned r; asm volatile("v_cvt_pk_f16_f32 %0, %1, %2" : "=v"(r) : "v"(lo), "v"(hi)); return r; }
typedef float f32x2 __attribute__((ext_vector_type(2)));

typedef _Float16 h16x2 __attribute__((ext_vector_type(2)));
__device__ __forceinline__ float bf_lo(unsigned w) { return (float)__builtin_bit_cast(h16x2, w)[0]; }
__device__ __forceinline__ float bf_hi(unsigned w) { return (float)__builtin_bit_cast(h16x2, w)[1]; }
__device__ __forceinline__ float fast_sigmoid(float x) { return __builtin_amdgcn_rcpf(1.0f + __builtin_amdgcn_exp2f(x * -1.4426950408889634f)); }
__device__ __forceinline__ float gelu_tanh(float x) { const float y = x * (0.7978845608028654f + 0.035677408136300125f * x * x); return x * __builtin_amdgcn_rcpf(1.0f + __builtin_amdgcn_exp2f(y * -2.8853900817779268f)); }
#ifndef PG8_WT
#define PG8_WT 0
#endif
__device__ __forceinline__ void st16(bf16_t* base, size_t elem_off, const u32x4 v) {
#if PG8_WT
    __amdgpu_buffer_rsrc_t r = __builtin_amdgcn_make_buffer_rsrc((void*)base, 0, 0x7FFFFFFF, 0x00020000);
    __builtin_amdgcn_raw_buffer_store_b128(v, r, (unsigned)(elem_off * 2), 0, 16);
#else
    *(u32x4*)(base + elem_off) = v;
#endif
}
__device__ __forceinline__ u32x4 pack8(const f32x4 v0, const f32x4 v1) { u32x4 w; w.x = cvt_pk_bf16(v0[0], v0[1]); w.y = cvt_pk_bf16(v0[2], v0[3]); w.z = cvt_pk_bf16(v1[0], v1[1]); w.w = cvt_pk_bf16(v1[2], v1[3]); return w; }


__device__ __forceinline__ float row_rstd16(const float* slots, float inv_n, float eps) {
    const f32x4 a = *(const f32x4*)(slots), b = *(const f32x4*)(slots + 4), c = *(const f32x4*)(slots + 8), d = *(const f32x4*)(slots + 12);
    const float s = ((a[0] + a[1]) + (a[2] + a[3])) + ((b[0] + b[1]) + (b[2] + b[3])) + ((c[0] + c[1]) + (c[2] + c[3])) + ((d[0] + d[1]) + (d[2] + d[3]));
    return 1.0f / sqrtf(s * inv_n + eps);
}
template <class Sched> __device__ __forceinline__ void build_rstd_table(PG8_LAS float* tab, const float* slots, const Sched& S, int tid) {
    int nr = 0; { Unit u; while (nr < 12 && S.next(nr, u)) ++nr; }
    for (int idx = tid; idx < nr * 256; idx += 512) { Unit u; S.next(idx >> 8, u); tab[idx] = row_rstd16(slots + ((size_t)u.pm * BM + (idx & 255)) * 16, 1.0f / 1024.0f, 1e-6f); }
    __syncthreads();
}
__device__ __forceinline__ float sum_fq(float v) {
    v += __int_as_float(__builtin_amdgcn_ds_swizzle(__float_as_int(v), 0x401F));
    auto rr = __builtin_amdgcn_permlane32_swap(__float_as_uint(v), __float_as_uint(v), false, false);
    return __uint_as_float(rr[0]) + __uint_as_float(rr[1]);
}
__device__ __forceinline__ int seq_of_row(int r) { return r < 16384 ? (r >> 13) : 2 + ((r - 16384) >> 11); }
__device__ __forceinline__ int seq_start_of_row(int r) { return r < 16384 ? (r & ~8191) : (r & ~2047); }
__device__ __forceinline__ int seq_len_of_row(int r) { return r < 16384 ? 8192 : 2048; }

struct EpiPlain {
    static constexpr bool PERM = true, AFTER_DRAIN = false;
    bf16_t* O; int ldc;
    __device__ __forceinline__ void operator()(const f32x4 (&acc)[2][2][4][2], const Unit& u, int wr, int wc, int fr, int fq) const {
        const int row0 = u.pm * BM + wr * 64 + fr, col0 = u.pn * BM + wc * 32 + 8 * fq;
#pragma unroll
        for (int ai = 0; ai < 2; ++ai)
#pragma unroll
            for (int m = 0; m < 4; ++m) { const size_t roff = (size_t)(row0 + ai * HALF + m * 16) * ldc + col0;
#pragma unroll
                for (int bj = 0; bj < 2; ++bj) st16(O, roff + bj * HALF, pack8(acc[ai][bj][m][0], acc[ai][bj][m][1])); }
    }
};
struct EpiProj {
    static constexpr bool PERM = true, AFTER_DRAIN = false;
    bf16_t *LAT, *U, *GV, *SGA, *SGB;
    const PG8_LAS float* rtab;
    const float* bias;
    int row_base;
    float* ssl;
    float* ssg;
    __device__ __forceinline__ void operator()(const f32x4 (&acc)[2][2][4][2], const Unit& u, int wr, int wc, int fr, int fq) const {
        const int pn = u.pn; bf16_t* base; int ldc, colt, act;
        float* sp = nullptr; int slot = 0;
        if (pn == 0) { sp = ssl; slot = wc; } else if (pn == 1) { sp = ssl; slot = 4 + wc; } else if (pn == 2) { sp = ssl; slot = 8 + wc; } else if (pn >= 7 && pn < 11) { sp = ssg; slot = 4 * (pn - 7) + wc; }
        if (pn < 3) { base = LAT; ldc = 768; colt = pn * BM; act = 0; }
        else if (pn < 7) { base = U; ldc = 1024; colt = (pn - 3) * BM; act = 1; }
        else if (pn < 11) { base = GV; ldc = 1024; colt = (pn - 7) * BM; act = 1; }
        else if (pn < 15) { base = SGA; ldc = 1024; colt = (pn - 11) * BM; act = 2; }
        else { base = SGB; ldc = 1024; colt = (pn - 15) * BM; act = 2; }
        const int row0 = u.pm * BM + wr * 64 + fr, col0 = colt + wc * 32 + 8 * fq;
        const float* bp = bias + (size_t)seq_of_row(row_base + u.pm * BM) * (41 * 256) + pn * BM + wc * 32 + 8 * fq;
        f32x4 bv[2][2];
#pragma unroll
        for (int bj = 0; bj < 2; ++bj)
#pragma unroll
            for (int n = 0; n < 2; ++n) bv[bj][n] = *(const f32x4*)(bp + bj * HALF + 4 * n);
#pragma unroll
        for (int ai = 0; ai < 2; ++ai)
#pragma unroll
            for (int m = 0; m < 4; ++m) { const int row = row0 + ai * HALF + m * 16; const size_t roff = (size_t)row * ldc + col0;
                const float rs = rtab[u.idx * 256 + (row - u.pm * BM)]; float ss = 0.f;
#pragma unroll
                for (int bj = 0; bj < 2; ++bj) { f32x4 v0 = acc[ai][bj][m][0] * rs + bv[bj][0], v1 = acc[ai][bj][m][1] * rs + bv[bj][1];
                    if (act == 1) {
#pragma unroll
                        for (int j = 0; j < 4; ++j) { v0[j] = gelu_tanh(v0[j]); v1[j] = gelu_tanh(v1[j]); } }
                    else if (act == 2) {
#pragma unroll
                        for (int j = 0; j < 4; ++j) { v0[j] = fast_sigmoid(v0[j]); v1[j] = fast_sigmoid(v1[j]); } }
                    if (bj == 0 || pn != 1) ss += ((v0[0] * v0[0] + v0[1] * v0[1]) + (v0[2] * v0[2] + v0[3] * v0[3])) + ((v1[0] * v1[0] + v1[1] * v1[1]) + (v1[2] * v1[2] + v1[3] * v1[3]));
                    st16(base, roff + bj * HALF, pack8(v0, v1)); }
                if (sp) { ss = sum_fq(ss); if (fq == 0) sp[(size_t)row * 16 + slot] = ss; } }
    }
};
template <bool ADD> struct EpiGate {
    static constexpr bool PERM = true, AFTER_DRAIN = false;
    const bf16_t* G; const bf16_t* T; bf16_t* O; int ldc;
    __device__ __forceinline__ void operator()(const f32x4 (&acc)[2][2][4][2], const Unit& u, int wr, int wc, int fr, int fq) const {
        const int row0 = u.pm * BM + wr * 64 + fr, col0 = u.pn * BM + wc * 32 + 8 * fq;
#pragma unroll
        for (int am = 0; am < 2; ++am) { const int ai = am;
            u32x4 gq[4][2], tq[4][2];
#pragma unroll
            for (int m = 0; m < 4; ++m) { const size_t off = (size_t)(row0 + ai * HALF + m * 16) * ldc + col0;
#pragma unroll
                for (int bj = 0; bj < 2; ++bj) { gq[m][bj] = *(const u32x4*)(G + off + bj * HALF); if (ADD) tq[m][bj] = *(const u32x4*)(T + off + bj * HALF); } }
            asm volatile("" ::: "memory");
#pragma unroll
            for (int m = 0; m < 4; ++m) { const size_t off = (size_t)(row0 + ai * HALF + m * 16) * ldc + col0;
#pragma unroll
                for (int bj = 0; bj < 2; ++bj) { f32x4 v0 = acc[ai][bj][m][0], v1 = acc[ai][bj][m][1];
                    const u32x4 g = gq[m][bj];
                    v0[0] *= bf_lo(g.x); v0[1] *= bf_hi(g.x); v0[2] *= bf_lo(g.y); v0[3] *= bf_hi(g.y); v1[0] *= bf_lo(g.z); v1[1] *= bf_hi(g.z); v1[2] *= bf_lo(g.w); v1[3] *= bf_hi(g.w);
                    if (ADD) { const u32x4 t = tq[m][bj];
                        v0[0] += bf_lo(t.x); v0[1] += bf_hi(t.x); v0[2] += bf_lo(t.y); v0[3] += bf_hi(t.y); v1[0] += bf_lo(t.z); v1[1] += bf_hi(t.z); v1[2] += bf_lo(t.w); v1[3] += bf_hi(t.w); }
                    st16(O, off + bj * HALF, pack8(v0, v1)); } }
            asm volatile("" ::: "memory"); }
    }
};
struct EpiRes {
    static constexpr bool PERM = true, AFTER_DRAIN = false;
    const float* XI32; const float* XI32s  ; const bf16_t* XI16; float* XO32; bf16_t* XO16; const float* gate; int gld; const float* av; bf16_t* HO; float* SS; int row_base;
    __device__ __forceinline__ void operator()(const f32x4 (&acc)[2][2][4][2], const Unit& u, int wr, int wc, int fr, int fq) const {
        const int row0 = u.pm * BM + wr * 64 + fr, col0 = u.pn * BM + wc * 32 + 8 * fq;
        const int sq = seq_of_row(row_base + u.pm * BM);
        const float* gv = gate + (size_t)sq * gld + col0;
        f32x4 g[2][2], a[2][2];
#pragma unroll
        for (int bj = 0; bj < 2; ++bj)
#pragma unroll
            for (int n = 0; n < 2; ++n) { g[bj][n] = *(const f32x4*)(gv + bj * HALF + 4 * n); a[bj][n] = HO ? *(const f32x4*)(av + (size_t)sq * 1024 + col0 + bj * HALF + 4 * n) : (f32x4){0.f, 0.f, 0.f, 0.f}; }
#pragma unroll
        for (int am = 0; am < 4; ++am) { const int ai = am >> 1, m0 = (am & 1) * 2;
            f32x4 xq[2][2][2];
            if (XI32) { const bool smp = row_base + u.pm * BM >= 16384; const float* xb = smp ? XI32s : XI32; const size_t xsub = smp ? (size_t)16384 * 1024 : 0;
#pragma unroll
                for (int mm = 0; mm < 2; ++mm) { const size_t off = (size_t)(row0 + ai * HALF + (m0 + mm) * 16) * 1024 + col0 - xsub;
#pragma unroll
                    for (int bj = 0; bj < 2; ++bj)
#pragma unroll
                        for (int n = 0; n < 2; ++n) xq[mm][bj][n] = *(const f32x4*)(xb + off + bj * HALF + 4 * n); }
            } else {
                u32x4 xh[2][2];
#pragma unroll
                for (int mm = 0; mm < 2; ++mm) { const size_t off = (size_t)(row0 + ai * HALF + (m0 + mm) * 16) * 1024 + col0;
#pragma unroll
                    for (int bj = 0; bj < 2; ++bj) xh[mm][bj] = *(const u32x4*)(XI16 + off + bj * HALF); }
#pragma unroll
                for (int mm = 0; mm < 2; ++mm)
#pragma unroll
                    for (int bj = 0; bj < 2; ++bj) { const u32x4 w = xh[mm][bj]; xq[mm][bj][0] = (f32x4){bf_lo(w.x), bf_hi(w.x), bf_lo(w.y), bf_hi(w.y)}; xq[mm][bj][1] = (f32x4){bf_lo(w.z), bf_hi(w.z), bf_lo(w.w), bf_hi(w.w)}; }
            }
            asm volatile("" ::: "memory");
#pragma unroll
            for (int mm = 0; mm < 2; ++mm) { const int m = m0 + mm; const int row = row0 + ai * HALF + m * 16; const size_t off = (size_t)row * 1024 + col0; float ss = 0.f;
#pragma unroll
                for (int bj = 0; bj < 2; ++bj) { f32x4 x[2];
#pragma unroll
                    for (int n = 0; n < 2; ++n) { x[n] = xq[mm][bj][n] + g[bj][n] * acc[ai][bj][m][n];
                        ss += (x[n][0] * x[n][0] + x[n][1] * x[n][1]) + (x[n][2] * x[n][2] + x[n][3] * x[n][3]); }
                    if (XO32) { *(f32x4*)(XO32 + off + bj * HALF) = x[0]; *(f32x4*)(XO32 + off + bj * HALF + 4) = x[1]; }
                    else st16(XO16, off + bj * HALF, pack8(x[0], x[1]));
                    if (HO) st16(HO, off + bj * HALF, pack8(x[0] * a[bj][0], x[1] * a[bj][1])); }
                if (HO) { ss = sum_fq(ss); if (fq == 0) SS[(size_t)row * 16 + u.pn * 4 + wc] = ss; } }
            asm volatile("" ::: "memory"); }
    }
};
struct EpiSwiglu {
    static constexpr bool PERM = true, AFTER_DRAIN = false;
    bf16_t* O; int ldc; const PG8_LAS float* rtab; const float* bias  ; int row_base;
    __device__ __forceinline__ void operator()(const f32x4 (&acc)[2][2][4][2], const Unit& u, int wr, int wc, int fr, int fq) const {
        const int row0 = u.pm * BM + wr * 64 + fr, col0 = u.pn * HALF + wc * 32 + 8 * fq;
        const float* bp = bias + (size_t)seq_of_row(row_base + u.pm * BM) * (41 * 256) + (19 + u.pn) * BM + wc * 32 + 8 * fq;
        f32x4 bv[2][2];
#pragma unroll
        for (int bj = 0; bj < 2; ++bj)
#pragma unroll
            for (int n = 0; n < 2; ++n) bv[bj][n] = *(const f32x4*)(bp + bj * HALF + 4 * n);
#pragma unroll
        for (int ai = 0; ai < 2; ++ai)
#pragma unroll
            for (int m = 0; m < 4; ++m) { const int row = row0 + ai * HALF + m * 16; f32x4 o[2];
                const float rs = rtab[u.idx * 256 + (row - u.pm * BM)];
#pragma unroll
                for (int n = 0; n < 2; ++n)
#pragma unroll
                    for (int j = 0; j < 4; ++j) { const float up = acc[ai][0][m][n][j] * rs + bv[0][n][j], gt = acc[ai][1][m][n][j] * rs + bv[1][n][j]; o[n][j] = up * gt * fast_sigmoid(gt); }
                st16(O, (size_t)row * ldc + col0, pack8(o[0], o[1])); }
    }
};
__device__ __forceinline__ float bf_lo2(unsigned w) { return bf_lo(w); }
__device__ __forceinline__ void stage_tile_f16(const f32x4 (&acc)[2][2][4][2], PG8_LAS unsigned char* lds, int wr, int wc, int fr, int fq) {
#pragma unroll
    for (int ai = 0; ai < 2; ++ai)
#pragma unroll
        for (int m = 0; m < 4; ++m) { const int row = ai * HALF + wr * 64 + m * 16 + fr;
#pragma unroll
            for (int bj = 0; bj < 2; ++bj) { const int chunk = bj * 16 + wc * 4 + fq;
                *(PG8_LAS u32x4*)(lds + row * 512 + ((chunk ^ (row & 31)) << 4)) = pack8(acc[ai][bj][m][0], acc[ai][bj][m][1]); } }
    asm volatile("s_waitcnt lgkmcnt(0)" ::: "memory"); __builtin_amdgcn_s_barrier(); asm volatile("" ::: "memory");
}
__device__ __forceinline__ u32x4 tile_chunk(const PG8_LAS unsigned char* lds, int row, int chunk) { return *(const PG8_LAS u32x4*)(lds + row * 512 + ((chunk ^ (row & 31)) << 4)); }
__device__ __forceinline__ void unpack8h(const u32x4 w, float (&o)[8]) { o[0] = bf_lo(w.x); o[1] = bf_hi(w.x); o[2] = bf_lo(w.y); o[3] = bf_hi(w.y); o[4] = bf_lo(w.z); o[5] = bf_hi(w.z); o[6] = bf_lo(w.w); o[7] = bf_hi(w.w); }
__device__ __forceinline__ u32x4 pack8h(const float (&x)[8]) { u32x4 w; w.x = cvt_pk_bf16(x[0], x[1]); w.y = cvt_pk_bf16(x[2], x[3]); w.z = cvt_pk_bf16(x[4], x[5]); w.w = cvt_pk_bf16(x[6], x[7]); return w; }
__device__ __forceinline__ void head_norm_rope_store(const u32x4 (&w)[12], const float pre_nope, const float pre_rope, const float oscale, const float* g, const float* rc, const float* rs, bf16_t* dbase, const size_t doff) {
    float s = 0.f;
#pragma unroll
    for (int j = 0; j < 12; ++j) { float x[8]; unpack8h(w[j], x); const float p = j < 8 ? pre_nope : pre_rope;
#pragma unroll
        for (int i = 0; i < 8; ++i) { const float y = x[i] * p; s += y * y; } }
    const float r = 1.0f / sqrtf(s * (1.f / 96.f) + 1e-6f);
    const float rn = r * pre_nope * oscale, rr = r * pre_rope * oscale;
#pragma unroll
    for (int j = 0; j < 8; ++j) { float x[8]; unpack8h(w[j], x);
#pragma unroll
        for (int i = 0; i < 8; ++i) x[i] = (x[i] * rn) * g[8 * j + i];
        st16(dbase, doff + 8 * j, pack8h(x)); }
#pragma unroll
    for (int jj = 0; jj < 2; ++jj) { float x1[8], x2[8], o1[8], o2[8]; unpack8h(w[8 + jj], x1); unpack8h(w[10 + jj], x2);
        const f32x4 ca = *(const f32x4*)(rc + 8 * jj), cb = *(const f32x4*)(rc + 8 * jj + 4), sa = *(const f32x4*)(rs + 8 * jj), sb = *(const f32x4*)(rs + 8 * jj + 4);
        const float c[8] = {ca[0], ca[1], ca[2], ca[3], cb[0], cb[1], cb[2], cb[3]}, sn[8] = {sa[0], sa[1], sa[2], sa[3], sb[0], sb[1], sb[2], sb[3]};
#pragma unroll
        for (int i = 0; i < 8; ++i) { const float a = (x1[i] * rr) * g[64 + 8 * jj + i], b = (x2[i] * rr) * g[80 + 8 * jj + i]; o1[i] = a * c[i] - b * sn[i]; o2[i] = b * c[i] + a * sn[i]; }
        st16(dbase, doff + 64 + 8 * jj, pack8h(o1)); st16(dbase, doff + 80 + 8 * jj, pack8h(o2)); }
}
struct EpiQ {
    static constexpr bool PERM = true, AFTER_DRAIN = true;
    bf16_t* Q; const float* ssl; const float* g; const float* rc0; const float* rs0; float qscale;
    __device__ __forceinline__ void operator()(const f32x4 (&)[2][2][4][2], const Unit&, int, int, int, int) const {}
    __device__ __forceinline__ void fused(const f32x4 (&acc)[2][2][4][2], const Unit& u, int wr, int wc, int fr, int fq, PG8_LAS unsigned char* lds, int wid, int lane) const {
        stage_tile_f16(acc, lds, wr, wc, fr, fq);
        const int tid = wid * 64 + lane, row = tid & 255, hh = tid >> 8, t = u.pm * BM + row, head = 2 * u.pn + hh, st = seq_start_of_row(t), sl = seq_len_of_row(t), s = t - st;
        u32x4 w[12];
#pragma unroll
        for (int j = 0; j < 12; ++j) w[j] = tile_chunk(lds, row, 16 * hh + j);
        const f32x4 sa = *(const f32x4*)(ssl + (size_t)t * 16), sb = *(const f32x4*)(ssl + (size_t)t * 16 + 4);
        const float rq = 1.0f / sqrtf((((sa[0] + sa[1]) + (sa[2] + sa[3])) + ((sb[0] + sb[1]) + (sb[2] + sb[3]))) * (1.f / 384.f) + 1e-6f);
        head_norm_rope_store(w, rq, rq, qscale, g, rc0 + s * 16, rs0 + s * 16, Q, ((size_t)st * 8 + (size_t)head * sl + s) * 96);
        asm volatile("s_waitcnt lgkmcnt(0)" ::: "memory"); __builtin_amdgcn_s_barrier(); asm volatile("" ::: "memory");
    }
};
struct EpiKV {
    static constexpr bool PERM = true, AFTER_DRAIN = true;
    bf16_t* K; bf16_t* V; const bf16_t* LAT; int latw; const float* ssl; const float* g; const float* rc0; const float* rs0;
    __device__ __forceinline__ void operator()(const f32x4 (&)[2][2][4][2], const Unit&, int, int, int, int) const {}
    __device__ __forceinline__ void fused(const f32x4 (&acc)[2][2][4][2], const Unit& u, int wr, int wc, int fr, int fq, PG8_LAS unsigned char* lds, int wid, int lane) const {
        stage_tile_f16(acc, lds, wr, wc, fr, fq);
        const int tid = wid * 64 + lane, row = tid & 255, hh = tid >> 8, t = u.pm * BM + row, head = 2 * u.pn + hh, st = seq_start_of_row(t), sl = seq_len_of_row(t), s = t - st;
        const size_t orow = (size_t)st * 8 + (size_t)head * sl + s;
        const f32x4 sk = *(const f32x4*)(ssl + (size_t)t * 16 + 8);
        const float rkv = 1.0f / sqrtf(((sk[0] + sk[1]) + (sk[2] + sk[3])) * (1.f / 256.f) + 1e-6f);
        u32x4 w[12];
#pragma unroll
        for (int j = 0; j < 8; ++j) w[j] = tile_chunk(lds, row, 16 * hh + j);
#pragma unroll
        for (int j = 0; j < 4; ++j) w[8 + j] = *(const u32x4*)(LAT + (size_t)t * latw + 384 + 8 * j);
        head_norm_rope_store(w, rkv, 1.0f, 1.0f, g, rc0 + s * 16, rs0 + s * 16, K, orow * 96);
#pragma unroll
        for (int j = 0; j < 8; ++j) { float x[8]; unpack8h(tile_chunk(lds, row, 16 * hh + 8 + j), x);
#pragma unroll
            for (int i = 0; i < 8; ++i) x[i] *= rkv;
            st16(V, orow * 64 + 8 * j, pack8h(x)); }
        asm volatile("s_waitcnt lgkmcnt(0)" ::: "memory"); __builtin_amdgcn_s_barrier(); asm volatile("" ::: "memory");
    }
};
template <int K, int LDA, int LDB, class Epi, class Sched, bool ALIGN_EPI = false, bool SP2 = false>
__device__ __forceinline__ void gemm_phase(PG8_LAS unsigned char* lds, const Gemm g, const Sched& S, const Epi& E, const int wave_sgpr) {
    int lane_; asm volatile("v_mbcnt_lo_u32_b32 %0, -1, 0\n\tv_mbcnt_hi_u32_b32 %0, -1, %0" : "=v"(lane_));
    const int wid = wave_sgpr, lane = lane_, tid = wid * 64 + lane, wr = wid >> 2, wc = wid & 3, fr = lane & 15, fq = lane >> 4;
    constexpr int nt = K / BK; static_assert(K % (2 * BK) == 0 && nt >= 2, "K must be a multiple of 128");
    unsigned voffA[2], voffB[2];
#pragma unroll
    for (int i = 0; i < 2; ++i) { int R, C; stage_rc(tid * 16 + i * 8192, R, C); const int Rb = Epi::PERM ? ((R & ~31) + perm32(R & 31)) : R;
        voffA[i] = (unsigned)(R * LDA + C) * 2u; voffB[i] = (unsigned)(Rb * LDB + C) * 2u; }
    const size_t kstep = (size_t)(BK * 2);
    const size_t hstepA = (size_t)HALF * LDA * 2, hstepB = (size_t)HALF * LDB * 2;
    const size_t tstepA = 2 * hstepA, tstepB = 2 * hstepB;
    const unsigned ldsw = (unsigned)wid * 1024u;
    const int aoff = lds_byte(wr * 64 + fr, fq * 8), boff = lds_byte(wc * 32 + fr, fq * 8);
#define PG8_SA(b, h) (((b) * 2 + (h)) * HTB)
#define PG8_SB(b, h) ((4 + (b) * 2 + (h)) * HTB)
#define PG8_STAGE(bufoff, gbase, voff) do { _Pragma("unroll") for (int _i = 0; _i < 2; ++_i) \
        __builtin_amdgcn_global_load_lds((const unsigned*)((const char*)(gbase) + (voff)[_i]), (PG8_LAS unsigned*)(lds + (bufoff) + ldsw + _i * 8192), 16, 0, 0); } while (0)
#define PG8_LDA(dst, b, h) do { _Pragma("unroll") for (int m = 0; m < 4; ++m) _Pragma("unroll") for (int k = 0; k < 2; ++k) dst[m][k] = *(const PG8_LAS bf16x8*)(lds + PG8_SA(b, h) + aoff + m * 2048 + k * 1024); } while (0)
#define PG8_LDB(dst, b, h) do { _Pragma("unroll") for (int n = 0; n < 2; ++n) _Pragma("unroll") for (int k = 0; k < 2; ++k) dst[n][k] = *(const PG8_LAS bf16x8*)(lds + PG8_SB(b, h) + boff + n * 2048 + k * 1024); } while (0)
#define PG8_MMA(ai, bj, At, Bt) do { __builtin_amdgcn_s_setprio(1); _Pragma("unroll") for (int m = 0; m < 4; ++m) _Pragma("unroll") for (int n = 0; n < 2; ++n) _Pragma("unroll") for (int k = 0; k < 2; ++k) \
        acc[ai][bj][m][n] = __builtin_amdgcn_mfma_f32_16x16x32_f16(Bt[n][k], At[m][k], acc[ai][bj][m][n], 0, 0, 0); __builtin_amdgcn_s_setprio(0); } while (0)
#define PG8_WAIT_V(n) asm volatile("s_waitcnt vmcnt(" #n ")" ::: "memory")
#define PG8_WAIT_L(n) asm volatile("s_waitcnt lgkmcnt(" #n ")" ::: "memory")
#define PG8_BAR __builtin_amdgcn_s_barrier()
#define PG8_SCHED __builtin_amdgcn_sched_barrier(0)
    Unit cur, nxt; int ui = 0;
    if (!S.next(0, cur)) return;
    f32x4 acc[2][2][4][2];
#pragma unroll
    for (int a = 0; a < 2; ++a)
#pragma unroll
        for (int b = 0; b < 2; ++b)
#pragma unroll
            for (int m = 0; m < 4; ++m)
#pragma unroll
                for (int n = 0; n < 2; ++n) acc[a][b][m][n] = (f32x4){0.f, 0.f, 0.f, 0.f};
    bf16x8 At[4][2], B0[2][2], B1[2][2];
    const char* cA = (const char*)g.A + (size_t)cur.pm * tstepA; const char* cB = (const char*)g.Bt + (size_t)cur.pn * tstepB;
    S.a_ready(cur);
    if constexpr (SP2) {
        PG8_STAGE(PG8_SB(0, 0), cB, voffB); PG8_STAGE(PG8_SB(0, 1), cB + hstepB, voffB); PG8_STAGE(PG8_SA(0, 0), cA, voffA); PG8_STAGE(PG8_SA(0, 1), cA + hstepA, voffA);
        if (wr == 1) PG8_BAR;
        PG8_WAIT_V(2); PG8_BAR;
        PG8_STAGE(PG8_SB(1, 0), cB + kstep, voffB); PG8_STAGE(PG8_SA(1, 0), cA + kstep, voffA); PG8_STAGE(PG8_SB(1, 1), cB + hstepB + kstep, voffB);
        PG8_WAIT_V(6); PG8_BAR;
    } else {
        PG8_STAGE(PG8_SB(0, 0), cB, voffB); PG8_STAGE(PG8_SA(0, 0), cA, voffA); PG8_STAGE(PG8_SB(0, 1), cB + hstepB, voffB); PG8_STAGE(PG8_SA(0, 1), cA + hstepA, voffA);
        if (wr == 1) PG8_BAR;
        PG8_WAIT_V(4); PG8_BAR;
        PG8_STAGE(PG8_SB(1, 0), cB + kstep, voffB); PG8_STAGE(PG8_SA(1, 0), cA + kstep, voffA); PG8_STAGE(PG8_SB(1, 1), cB + hstepB + kstep, voffB);
        PG8_WAIT_V(6); PG8_BAR;
    }
    for (;;) {
        const bool has_next = S.next(ui + 1, nxt);
        const char* nA = has_next ? (const char*)g.A + (size_t)nxt.pm * tstepA : cA; const char* nB = has_next ? (const char*)g.Bt + (size_t)nxt.pn * tstepB : cB;
#pragma nounroll
        for (int t = 0; t < nt; t += 2) {
            const bool last = (t == nt - 2);
            const char* a1 = cA + (size_t)(t + 1) * kstep;
            const char* a2 = last ? nA : cA + (size_t)(t + 2) * kstep; const char* b2 = last ? nB : cB + (size_t)(t + 2) * kstep;
            const char* a3 = a2 + kstep; const char* b3 = b2 + kstep;
            if (last && has_next) S.a_ready(nxt);
            if constexpr (SP2) {
            PG8_LDB(B0, 0, 0); PG8_LDB(B1, 0, 1); PG8_SCHED; PG8_LDA(At, 0, 0); PG8_STAGE(PG8_SA(1, 1), a1 + hstepA, voffA);
            PG8_WAIT_V(8); PG8_WAIT_L(0); PG8_BAR; PG8_MMA(0, 0, At, B0); PG8_MMA(0, 1, At, B1); PG8_BAR; PG8_SCHED;
            PG8_LDA(At, 0, 1); PG8_STAGE(PG8_SB(0, 0), b2, voffB); PG8_STAGE(PG8_SB(0, 1), b2 + hstepB, voffB); PG8_STAGE(PG8_SA(0, 0), a2, voffA);
            PG8_WAIT_V(8); PG8_WAIT_L(0); PG8_BAR; PG8_MMA(1, 0, At, B0); PG8_MMA(1, 1, At, B1); PG8_BAR; PG8_SCHED;
            PG8_LDB(B0, 1, 0); PG8_LDB(B1, 1, 1); PG8_SCHED; PG8_LDA(At, 1, 0); PG8_STAGE(PG8_SA(0, 1), a2 + hstepA, voffA);
            PG8_WAIT_V(8); PG8_WAIT_L(0); PG8_BAR; PG8_MMA(0, 0, At, B0); PG8_MMA(0, 1, At, B1); PG8_BAR; PG8_SCHED;
            PG8_LDA(At, 1, 1); PG8_STAGE(PG8_SB(1, 0), b3, voffB); PG8_STAGE(PG8_SB(1, 1), b3 + hstepB, voffB); PG8_STAGE(PG8_SA(1, 0), a3, voffA);
            PG8_WAIT_V(8); PG8_WAIT_L(0); PG8_BAR; PG8_MMA(1, 0, At, B0); PG8_MMA(1, 1, At, B1); PG8_BAR; PG8_SCHED;
            } else {
            PG8_LDB(B0, 0, 0); PG8_SCHED; PG8_LDA(At, 0, 0); PG8_STAGE(PG8_SA(1, 1), a1 + hstepA, voffA);
            PG8_WAIT_L(8); PG8_BAR; PG8_WAIT_L(0); PG8_MMA(0, 0, At, B0); PG8_BAR; PG8_SCHED;
            PG8_LDB(B1, 0, 1); PG8_STAGE(PG8_SB(0, 0), b2, voffB);
            PG8_BAR; PG8_WAIT_L(0); PG8_MMA(0, 1, At, B1); PG8_BAR;
            PG8_LDA(At, 0, 1); PG8_STAGE(PG8_SA(0, 0), a2, voffA);
            PG8_BAR; PG8_WAIT_L(0); PG8_MMA(1, 0, At, B0); PG8_BAR; PG8_SCHED;
            PG8_STAGE(PG8_SB(0, 1), b2 + hstepB, voffB);
            PG8_WAIT_V(6); PG8_BAR; PG8_MMA(1, 1, At, B1); PG8_BAR;
            PG8_LDB(B0, 1, 0); PG8_SCHED; PG8_LDA(At, 1, 0); PG8_STAGE(PG8_SA(0, 1), a2 + hstepA, voffA);
            PG8_WAIT_L(8); PG8_BAR; PG8_WAIT_L(0); PG8_MMA(0, 0, At, B0); PG8_BAR; PG8_SCHED;
            PG8_LDB(B1, 1, 1); PG8_STAGE(PG8_SB(1, 0), b3, voffB);
            PG8_BAR; PG8_WAIT_L(0); PG8_MMA(0, 1, At, B1); PG8_BAR;
            PG8_LDA(At, 1, 1); PG8_STAGE(PG8_SA(1, 0), a3, voffA);
            PG8_BAR; PG8_WAIT_L(0); PG8_MMA(1, 0, At, B0); PG8_BAR; PG8_SCHED;
            PG8_STAGE(PG8_SB(1, 1), b3 + hstepB, voffB);
            PG8_WAIT_V(6); PG8_BAR; PG8_MMA(1, 1, At, B1); PG8_BAR;
            }
        }
        if constexpr (ALIGN_EPI) { if (wr == 0) PG8_BAR; }
        if constexpr (!Epi::AFTER_DRAIN) { E(acc, cur, wr, wc, fr, fq); S.done(cur); }
        if (!has_next) break;
#pragma unroll
        for (int a = 0; a < 2; ++a)
#pragma unroll
            for (int b = 0; b < 2; ++b)
#pragma unroll
                for (int m = 0; m < 4; ++m)
#pragma unroll
                    for (int n = 0; n < 2; ++n) acc[a][b][m][n] = (f32x4){0.f, 0.f, 0.f, 0.f};
        cur = nxt; cA = nA; cB = nB; ++ui;
        if constexpr (ALIGN_EPI) { if (wr == 1) PG8_BAR; }
    }
    PG8_WAIT_V(0);
    if constexpr (!ALIGN_EPI) { if (wr == 0) PG8_BAR; }
    PG8_BAR;
    if constexpr (Epi::AFTER_DRAIN) { E.fused(acc, cur, wr, wc, fr, fq, lds, wid, lane); S.done(cur); }
#undef PG8_SA
#undef PG8_SB
#undef PG8_STAGE
#undef PG8_LDA
#undef PG8_LDB
#undef PG8_MMA
#undef PG8_WAIT_V
#undef PG8_WAIT_L
#undef PG8_BAR
#undef PG8_SCHED
}
}

namespace att2 {
typedef unsigned short bf16;
using bf16x8=__attribute__((ext_vector_type(8)))short;
using s16x4=__attribute__((ext_vector_type(4)))short;
using f32x16=__attribute__((ext_vector_type(16)))float;
using u32x4=__attribute__((ext_vector_type(4)))unsigned;
typedef _Float16 h16x8 __attribute__((ext_vector_type(8)));
constexpr int DQK=96,DV=64,OPITCH=512;
constexpr int NW=8,QBLK=32,QB=QBLK*NW,KVBLK=64;
__device__ __forceinline__ int crow(int r,int hi){return (r&3)+8*(r>>2)+4*hi;}
#define SBAR() __builtin_amdgcn_sched_barrier(0)
#define MFMA32(a,b,c) __builtin_amdgcn_mfma_f32_32x32x16_f16(__builtin_bit_cast(h16x8,a),__builtin_bit_cast(h16x8,b),c,0,0,0)
constexpr int NSLOT=3, KSLOT=12288, VSLOT=8192;
constexpr int LDS_K=0, LDS_V=NSLOT*KSLOT, LDS_WS=LDS_V+NSLOT*VSLOT, LDS_OST=LDS_WS+NW*64*4, LDS_BYTES=LDS_OST+NW*4096;
constexpr float QSCALE=0.10206207261596575f*1.4426950408889634f;
__device__ __forceinline__ void glds16(const void*gsrc,unsigned lds_dst){unsigned keep;
  asm volatile("s_mov_b32 %0, m0\n\ts_mov_b32 m0, %2\n\ts_nop 0\n\tglobal_load_lds_dwordx4 %1, off\n\ts_mov_b32 m0, %0":"=&s"(keep):"v"(gsrc),"s"(lds_dst):"memory");}
__device__ __forceinline__ float max3f(float a,float b,float c){float r;asm("v_max3_f32 %0, %1, %2, %3":"=v"(r):"v"(a),"v"(b),"v"(c));return r;}
__device__ __forceinline__ float max2f(float a,float b){float r;asm("v_max_f32_e32 %0, %1, %2":"=v"(r):"v"(a),"v"(b));return r;}
__device__ __forceinline__ float fadd_s(float a,float b){float r;asm("v_add_f32_e32 %0, %1, %2":"=v"(r):"v"(a),"v"(b));return r;}
__device__ __forceinline__ float fsub_s(float a,float b){float r;asm("v_sub_f32_e32 %0, %1, %2":"=v"(r):"v"(a),"v"(b));return r;}
typedef float f32x2_t __attribute__((ext_vector_type(2))); typedef _Float16 h16x2_t __attribute__((ext_vector_type(2)));
__device__ __forceinline__ unsigned cvtpk_s(float lo,float hi){f32x2_t v={lo,hi};h16x2_t b=__builtin_convertvector(v,h16x2_t);return __builtin_bit_cast(unsigned,b);}
#define WAIT_BAR(N) asm volatile("s_waitcnt vmcnt(" #N ") lgkmcnt(0)\n\ts_barrier":::"memory")

__device__ __forceinline__ void qkt(f32x16&p0,f32x16&p1,const char*Kslot,const bf16x8*qr,const f32x16&negm,int r32,int hi){
  const char*kb=Kslot+hi*1024+r32*16;
  #pragma unroll
  for(int d0=0;d0<6;++d0){
    const bf16x8 b0=*reinterpret_cast<const bf16x8*>(kb+d0*2048);
    const bf16x8 b1=*reinterpret_cast<const bf16x8*>(kb+d0*2048+512);
    if(d0==0){p0=MFMA32(b0,qr[0],negm);p1=MFMA32(b1,qr[0],negm);}
    else{p0=MFMA32(b0,qr[d0],p0);p1=MFMA32(b1,qr[d0],p1);}}
}
typedef __attribute__((address_space(3))) const char* lds_cptr;
typedef short v4i16_t __attribute__((ext_vector_type(4)));
__device__ __forceinline__ void kload2(bf16x8*kf,lds_cptr kp,int j){ kf[2*j]=*(const __attribute__((address_space(3))) bf16x8*)(kp+j*2048); kf[2*j+1]=*(const __attribute__((address_space(3))) bf16x8*)(kp+j*2048+512); }
__device__ __forceinline__ s16x4 vtr(lds_cptr p){ return __builtin_bit_cast(s16x4,__builtin_amdgcn_ds_read_tr16_b64_v4i16((__attribute__((address_space(3))) v4i16_t*)p)); }
__device__ __forceinline__ float rowmax(const f32x16&p0,const f32x16&p1){
  float a=max3f(p0[0],p0[1],p1[0]),b=max3f(p0[2],p0[3],p1[1]);a=max3f(a,p1[2],p1[3]);
  #pragma unroll
  for(int r=4;r<16;r+=4){a=max3f(a,p0[r],p0[r+1]);b=max3f(b,p0[r+2],p0[r+3]);a=max3f(a,p1[r],p1[r+1]);b=max3f(b,p1[r+2],p1[r+3]);}
  const float m=max2f(a,b);
  auto rr=__builtin_amdgcn_permlane32_swap(__float_as_uint(m),__float_as_uint(m),false,false);
  return max2f(__uint_as_float(rr[0]),__uint_as_float(rr[1]));
}
__device__ __forceinline__ void pv(f32x16*o,int vb,bf16x8 pa0,bf16x8 pa1,bf16x8 pa2,bf16x8 pa3){
  #pragma unroll
  for(int d0=0;d0<2;++d0){s16x4 lo[4],hi[4];
    #pragma unroll
    for(int ks=0;ks<4;++ks){
      asm volatile("ds_read_b64_tr_b16 %0,%1 offset:%c2":"=&v"(lo[ks]):"v"(vb),"i"(d0*4096+ks*1024):"memory");
      asm volatile("ds_read_b64_tr_b16 %0,%1 offset:%c2":"=&v"(hi[ks]):"v"(vb),"i"(d0*4096+ks*1024+512):"memory");}
    asm volatile("s_waitcnt lgkmcnt(0)":::"memory");SBAR();
    #define PK(k) (bf16x8){lo[k][0],lo[k][1],lo[k][2],lo[k][3],hi[k][0],hi[k][1],hi[k][2],hi[k][3]}
    o[d0]=MFMA32(pa0,PK(0),o[d0]);
    o[d0]=MFMA32(pa1,PK(1),o[d0]);
    o[d0]=MFMA32(pa2,PK(2),o[d0]);
    o[d0]=MFMA32(pa3,PK(3),o[d0]);
    #undef PK
  }
}

template<int THRL> __device__ __forceinline__ void attn_unit(const int wave_sgpr,const bf16*Qu,const bf16*__restrict__ Kh,const bf16*__restrict__ Vh,bf16*Ou,const int NT,char*shm){
  int lane_; asm volatile("v_mbcnt_lo_u32_b32 %0, -1, 0\n\tv_mbcnt_hi_u32_b32 %0, -1, %0" : "=v"(lane_));
  const int lane=lane_,r32=lane&31,hi=lane>>5; const int wid=wave_sgpr;
  const bf16*Qw=Qu+(long)(wid*QBLK)*DQK;
  const unsigned lds0=(unsigned)(uintptr_t)shm;
  float*wsf=(float*)(shm+LDS_WS)+wid*64;
  const int kcB=8+(wid&3);
  const bf16*ksrcA=Kh+(long)lane*DQK+wid*8;
  const bf16*ksrcB=Kh+(long)lane*DQK+kcB*8;
  const bf16*vsrc=Vh+(long)(16*(wid&3)+(lane>>2))*DV+(wid>>2)*32+(lane&3)*8;
  const unsigned kdstA=lds0+LDS_K+wid*1024, kdstB=lds0+LDS_K+kcB*1024, vdst=lds0+LDS_V+wid*1024;
  #define DMA_K(t,si) do{ glds16(ksrcA+(long)(t)*KVBLK*DQK,(unsigned)__builtin_amdgcn_readfirstlane(kdstA+(si)*KSLOT)); glds16(ksrcB+(long)(t)*KVBLK*DQK,(unsigned)__builtin_amdgcn_readfirstlane(kdstB+(si)*KSLOT)); }while(0)
  #define DMA_V(t,si) glds16(vsrc+(long)(t)*KVBLK*DV,(unsigned)__builtin_amdgcn_readfirstlane(vdst+(si)*VSLOT))
  const int vb0=(int)(lds0+LDS_V)+((lane>>4)&1)*32+(lane&3)*8+(4*hi+((lane&15)>>2))*64;
  const char*Kbase=shm+LDS_K; bf16x8 kf[12];
  const lds_cptr shm3=(lds_cptr)shm; const lds_cptr kp0=shm3+LDS_K+hi*1024+r32*16; const lds_cptr vp0=shm3+LDS_V+((lane>>4)&1)*32+(lane&3)*8+(4*hi+((lane&15)>>2))*64;
  DMA_K(0,0);DMA_V(0,0);DMA_K(1,1);
  bf16x8 qr[6];
  #pragma unroll
  for(int d0=0;d0<6;++d0)qr[d0]=*reinterpret_cast<const bf16x8*>(&Qw[(long)r32*DQK+d0*16+hi*8]);
  float mhat=0.f,l_reg=0.f;f32x16 o[2];o[0]=f32x16{};o[1]=f32x16{};f32x16 negm=f32x16{};asm volatile("":"+v"(negm));
  bool resc=false;
  #define START(P0,P1) do{ const float rm=rowmax(P0,P1); resc=false; \
    { const float dl=rm; mhat=fadd_s(mhat,dl); \
      _Pragma("unroll") for(int r=0;r<16;++r){P0[r]=fsub_s(P0[r],dl);P1[r]=fsub_s(P1[r],dl);} \
      _Pragma("unroll") for(int r=0;r<16;++r)negm[r]=-mhat; asm volatile("":"+v"(negm)); } \
    _Pragma("unroll") for(int r=0;r<16;++r)P0[r]=__builtin_amdgcn_exp2f(P0[r]); }while(0)
  #define RESC() do{ if(resc){ asm volatile("s_waitcnt lgkmcnt(0)":::"memory"); \
      _Pragma("unroll") for(int d_=0;d_<2;++d_) _Pragma("unroll") for(int r=0;r<16;++r)o[d_][r]*=wsf[crow(r,hi)]; } }while(0)
  f32x16 pA0,pA1,pB0,pB1;
  int sl_prev=0,sl_cur=0,sl_next=1;
  #define ROT() do{sl_prev=sl_cur;sl_cur=sl_next;sl_next=(sl_next==NSLOT-1)?0:sl_next+1;}while(0)
  DMA_K(2,2);
  WAIT_BAR(5);
  qkt(pA0,pA1,Kbase,qr,negm,r32,hi);asm volatile("s_nop 15\n\ts_nop 7":"+v"(pA0),"+v"(pA1));
  START(pA0,pA1);
  _Pragma("unroll") for(int r=0;r<16;++r)pA1[r]=__builtin_amdgcn_exp2f(pA1[r]);
  WAIT_BAR(0);
  DMA_K(3,0);DMA_V(1,1);
  ROT();
  #pragma unroll
  for(int j=0;j<6;++j)kload2(kf,kp0+sl_cur*KSLOT,j);
  WAIT_BAR(3);
  s16x4 vlo[8],vhi[8]; u32x4 pw0,pw1,pw2,pw3;
  #define PKW(P,B) cvtpk_s(P[B],P[B+1])
  #define PAF(k) __builtin_bit_cast(bf16x8,pw##k)
  #define VFR(i) (bf16x8){vlo[i][0],vlo[i][1],vlo[i][2],vlo[i][3],vhi[i][0],vhi[i][1],vhi[i][2],vhi[i][3]}
  #define PIN(x) asm volatile("":"+v"(x))
  #define MX3(a,b,c) __builtin_fmaxf(__builtin_fmaxf((a),(b)),(c))
  #define EX(v) __builtin_amdgcn_exp2f(v)
  #define GAPB(MF,X,B) do{ MF; X[B]=EX(X[B]); X[B+1]=EX(X[B+1]); X[B+2]=EX(X[B+2]); X[B+3]=EX(X[B+3]); PIN(X); SBAR(); }while(0)
  #define VRD(i) do{ vlo[i]=vtr(vp_+(((i)>>2)*4096+((i)&3)*1024)); vhi[i]=vtr(vp_+(((i)>>2)*4096+((i)&3)*1024+512)); }while(0)
  #define KRD(G,j) do{ if(G){ kload2(kf,kp0+sl_next*KSLOT,j); SBAR(); } }while(0)
  #define STEP(C0,C1,P0,P1,t,GK,GV,GL) do{ SBAR(); \
    const lds_cptr vp_=vp0+sl_prev*VSLOT; \
    VRD(0); SBAR(); float sacc=(P0[0]+P0[1]); \
    C0=MFMA32(kf[0],qr[0],negm); sacc+=P0[2]; sacc+=P0[3]; sacc+=P0[4]; PIN(sacc); pw0[0]=PKW(P0,0); pw0[1]=PKW(P0,2); PIN(pw0); SBAR(); \
    VRD(4); SBAR(); C1=MFMA32(kf[1],qr[0],negm); sacc+=P0[5]; sacc+=P0[6]; sacc+=P0[7]; PIN(sacc); pw0[2]=PKW(P0,4); PIN(pw0); SBAR(); \
    VRD(1); SBAR(); C0=MFMA32(kf[2],qr[1],C0); sacc+=P0[8]; sacc+=P0[9]; sacc+=P0[10]; PIN(sacc); pw0[3]=PKW(P0,6); pw1[0]=PKW(P0,8); PIN(pw0); PIN(pw1); SBAR(); \
    VRD(5); SBAR(); C1=MFMA32(kf[3],qr[1],C1); sacc+=P0[11]; sacc+=P0[12]; sacc+=P0[13]; PIN(sacc); pw1[1]=PKW(P0,10); PIN(pw1); SBAR(); \
    VRD(2); SBAR(); C0=MFMA32(kf[4],qr[2],C0); sacc+=P0[14]; sacc+=P0[15]; sacc+=P1[0]; PIN(sacc); pw1[2]=PKW(P0,12); pw1[3]=PKW(P0,14); PIN(pw1); SBAR(); \
    VRD(6); SBAR(); C1=MFMA32(kf[5],qr[2],C1); sacc+=P1[1]; sacc+=P1[2]; sacc+=P1[3]; PIN(sacc); pw2[0]=PKW(P1,0); PIN(pw2); SBAR(); \
    VRD(3); SBAR(); C0=MFMA32(kf[6],qr[3],C0); sacc+=P1[4]; sacc+=P1[5]; sacc+=P1[6]; PIN(sacc); pw2[1]=PKW(P1,2); pw2[2]=PKW(P1,4); PIN(pw2); SBAR(); \
    VRD(7); SBAR(); C1=MFMA32(kf[7],qr[3],C1); sacc+=P1[7]; sacc+=P1[8]; sacc+=P1[9]; PIN(sacc); pw2[3]=PKW(P1,6); PIN(pw2); SBAR(); \
    C0=MFMA32(kf[8],qr[4],C0); sacc+=P1[10]; sacc+=P1[11]; PIN(sacc); pw3[0]=PKW(P1,8); PIN(pw3); SBAR(); \
    C1=MFMA32(kf[9],qr[4],C1); sacc+=P1[12]; sacc+=P1[13]; PIN(sacc); pw3[1]=PKW(P1,10); PIN(pw3); SBAR(); \
    C0=MFMA32(kf[10],qr[5],C0); sacc+=P1[14]; PIN(sacc); pw3[2]=PKW(P1,12); PIN(pw3); SBAR(); \
    C1=MFMA32(kf[11],qr[5],C1); sacc+=P1[15]; PIN(sacc); pw3[3]=PKW(P1,14); PIN(pw3); SBAR(); \
    l_reg+=sacc; \
    if(GK){DMA_K((t)+3,sl_cur);} if(GV){DMA_V((t)+1,sl_next);} \
    { float a=MX3(C0[0],C0[1],C1[0]),b=MX3(C0[2],C0[3],C1[1]); a=MX3(a,C1[2],C1[3]); \
      _Pragma("unroll") for(int r=4;r<16;r+=4){a=MX3(a,C0[r],C0[r+1]);b=MX3(b,C0[r+2],C0[r+3]);a=MX3(a,C1[r],C1[r+1]);b=MX3(b,C1[r+2],C1[r+3]);} \
      float rm=__builtin_fmaxf(a,b); { auto rr=__builtin_amdgcn_permlane32_swap(__float_as_uint(rm),__float_as_uint(rm),false,false); rm=__builtin_fmaxf(__uint_as_float(rr[0]),__uint_as_float(rr[1])); } \
      resc=false; \
      if(__builtin_expect(__any(rm>(float)THRL),0)){ const float dl=__builtin_fmaxf(rm,0.f); mhat+=dl; \
        _Pragma("unroll") for(int r=0;r<16;++r){C0[r]-=dl;C1[r]-=dl;} \
        _Pragma("unroll") for(int r=0;r<16;++r)negm[r]=-mhat; asm volatile("":"+v"(negm)); \
        const float f=__builtin_amdgcn_exp2f(-dl); l_reg*=f; if(hi==0)wsf[r32]=f; resc=true; } } \
    SBAR(); \
    GAPB(o[0]=MFMA32(PAF(0),VFR(0),o[0]), C0,0); \
    KRD(GL,0); GAPB(o[1]=MFMA32(PAF(0),VFR(4),o[1]), C0,4); \
    KRD(GL,1); GAPB(o[0]=MFMA32(PAF(1),VFR(1),o[0]), C0,8); \
    KRD(GL,2); GAPB(o[1]=MFMA32(PAF(1),VFR(5),o[1]), C0,12); \
    KRD(GL,3); GAPB(o[0]=MFMA32(PAF(2),VFR(2),o[0]), C1,0); \
    KRD(GL,4); GAPB(o[1]=MFMA32(PAF(2),VFR(6),o[1]), C1,4); \
    KRD(GL,5); GAPB(o[0]=MFMA32(PAF(3),VFR(3),o[0]), C1,8); \
    GAPB(o[1]=MFMA32(PAF(3),VFR(7),o[1]), C1,12); \
    }while(0)
  int t=1;
  for(;t+5<NT;t+=2){
    STEP(pB0,pB1,pA0,pA1,t,true,true,true);     WAIT_BAR(3); RESC(); ROT();
    STEP(pA0,pA1,pB0,pB1,t+1,true,true,true);   WAIT_BAR(3); RESC(); ROT();
  }
  #define ENDW(tt) do{ if((tt)+3<NT){WAIT_BAR(3);} else if((tt)+2<NT){WAIT_BAR(1);} else {WAIT_BAR(0);} }while(0)
  for(;t+1<NT;t+=2){
    STEP(pB0,pB1,pA0,pA1,t,(t+3<NT),(t+1<NT),(t+1<NT));       ENDW(t);   RESC(); ROT();
    STEP(pA0,pA1,pB0,pB1,t+1,(t+4<NT),(t+2<NT),(t+2<NT));     ENDW(t+1); RESC(); ROT();
  }
  STEP(pB0,pB1,pA0,pA1,NT-1,false,false,false); RESC();
  { float sacc=pB0[0]+pB0[1]; _Pragma("unroll") for(int r=2;r<16;++r)sacc+=pB0[r]; _Pragma("unroll") for(int r=0;r<16;++r)sacc+=pB1[r]; l_reg+=sacc;
    pw0=(u32x4){PKW(pB0,0),PKW(pB0,2),PKW(pB0,4),PKW(pB0,6)};pw1=(u32x4){PKW(pB0,8),PKW(pB0,10),PKW(pB0,12),PKW(pB0,14)};pw2=(u32x4){PKW(pB1,0),PKW(pB1,2),PKW(pB1,4),PKW(pB1,6)};pw3=(u32x4){PKW(pB1,8),PKW(pB1,10),PKW(pB1,12),PKW(pB1,14)};
    SBAR(); pv(o,vb0+sl_cur*VSLOT,PAF(0),PAF(1),PAF(2),PAF(3)); }
  #undef PKW
  #undef PAF
  #undef VFR
  #undef PIN
  #undef MX3
  #undef GAPB
  #undef EX
  #undef VRD
  #undef KRD
  #undef STEP
  #undef ENDW
  {auto rr=__builtin_amdgcn_permlane32_swap(__float_as_uint(l_reg),__float_as_uint(l_reg),false,false);l_reg=__uint_as_float(rr[0])+__uint_as_float(rr[1]);}
  if(hi==0)wsf[32+r32]=l_reg;asm volatile("s_waitcnt lgkmcnt(0)":::"memory");
  float rli[16];
  #pragma unroll
  for(int r=0;r<16;++r)rli[r]=__builtin_amdgcn_rcpf(wsf[32+crow(r,hi)]);
  bf16*Ow=Ou+(long)(wid*QBLK)*OPITCH;
  { bf16*stg=(bf16*)(shm+LDS_OST)+wid*2048;
    #pragma unroll
    for(int r=0;r<16;++r){const int orow=crow(r,hi);
      #pragma unroll
      for(int d0=0;d0<2;++d0)stg[orow*64+d0*32+r32]=(bf16)(cvtpk_s(o[d0][r]*rli[r],0.f)&0xffffu);}
    asm volatile("s_waitcnt lgkmcnt(0)":::"memory");
    #pragma unroll
    for(int i=0;i<4;++i){const int row=i*8+(lane>>3),ch=lane&7; const u32x4 v=*(const u32x4*)(stg+row*64+ch*8); *(u32x4*)(Ow+(long)row*OPITCH+ch*8)=v;} }
  asm volatile("s_waitcnt lgkmcnt(0)\n\ts_barrier":::"memory");
  #undef DMA_K
  #undef DMA_V
  #undef START
  #undef RESC
  #undef ROT
}
#undef SBAR
#undef WAIT_BAR
#undef MFMA32
}


constexpr int NWAVES = 8;
constexpr int DM = 1024, NL = 4, TG = 16384  , NGRP = 2, NB = 10  ;
constexpr int TT = NGRP * TG;
constexpr int NH = 8, DQK = 96, DV = 64, QLORA = 384, KVLORA = 256, DROPE = 32, NIN = 4768, NINP = 4864, DFF = 2816, NMOD = 6 * DM;
constexpr int LATW = 768;
constexpr float EPS = 1e-6f;
constexpr int KSPLIT = 8;
constexpr int BIASW = 41 * 256;
#ifndef MK_ONE_LAUNCH
#define MK_ONE_LAUNCH 1
#endif

constexpr size_t MiB = 1u << 20;
constexpr size_t WS_CTL = 0, CTL_ZERO_BYTES = 1 * MiB;
constexpr size_t WS_MOD = 1 * MiB;
constexpr size_t WS_ROPE = 2 * MiB;
constexpr size_t WS_AV = 3 * MiB;
constexpr size_t WS_MODP = 4 * MiB;
constexpr size_t WS_SSL = 4 * MiB, WS_SSG = 6 * MiB;
constexpr size_t WS_BIAS = 12 * MiB;
constexpr size_t WS_SSX = 14 * MiB;
constexpr size_t WS_WB = 16 * MiB, WB_LAYER = 65 * 512 * 1024;
constexpr size_t WO_IN = 0, WO_FI = WO_IN + (size_t)NINP * DM, WO_QB = WO_FI + (size_t)2 * DFF * DM, WO_KVB = WO_QB + (size_t)1024 * QLORA, WO_OA = WO_KVB + (size_t)1024 * KVLORA, WO_S = WO_OA + (size_t)DM * 512,
                 WO_OB = WO_S + (size_t)8 * 128 * 128, WO_OUT = WO_OB + (size_t)DM * DM, WO_FO = WO_OUT + (size_t)DM * DM, WO_END = WO_FO + (size_t)DM * DFF;
static_assert(WO_END * 2 <= WB_LAYER, "layer weight block");
constexpr size_t WS_HH = 81 * MiB;
constexpr size_t WS_X16 = 145 * MiB;
constexpr size_t WS_U = 209 * MiB, WS_GV = 273 * MiB, WS_SGA = 337 * MiB, WS_SGB = 401 * MiB, WS_END = 465 * MiB;
constexpr size_t WS_ACT = WS_U;
static_assert(WS_ACT + (size_t)TT * DFF * 2 <= WS_SGB && WS_WB + 2 * WB_LAYER <= WS_HH && WS_SSG + (size_t)TT * 64 <= WS_BIAS, "d_ws map");
constexpr size_t DO_K = 0, DO_V = 48 * MiB, DO_LAT = 80 * MiB;
static_assert(DO_LAT + (size_t)TT * LATW * 2 <= (size_t)TT * DM * 4, "d_out scratch map");
constexpr int CW_BAR = 4096;

constexpr int RING_BYTES = 131072;
constexpr int LDSCTL_OFF = RING_BYTES, MISC_OFF = LDSCTL_OFF + 320;
constexpr int LDS_BYTES = 147456;
constexpr int RTAB_OFF = 132096;

#define GAS __attribute__((address_space(1)))
#define LAS __attribute__((address_space(3)))
typedef unsigned short bf16;
typedef unsigned v4u __attribute__((ext_vector_type(4)));
typedef unsigned v2u __attribute__((ext_vector_type(2)));
typedef float f32x4 __attribute__((ext_vector_type(4)));
typedef short bf16x8 __attribute__((ext_vector_type(8)));
#define LDS_WAIT() asm volatile("s_waitcnt lgkmcnt(0)" ::: "memory")
typedef _Float16 h16x2 __attribute__((ext_vector_type(2)));
typedef _Float16 h16x8 __attribute__((ext_vector_type(8)));
typedef float f32x2 __attribute__((ext_vector_type(2)));
__device__ __forceinline__ unsigned f2bf(float f) { return (unsigned)__builtin_bit_cast(unsigned short, (_Float16)f); }
__device__ __forceinline__ unsigned pk2(float lo, float hi) { const f32x2 v = {lo, hi}; return __builtin_bit_cast(unsigned, __builtin_convertvector(v, h16x2)); }
__device__ __forceinline__ float bflo(unsigned w) { return (float)__builtin_bit_cast(h16x2, w)[0]; }
__device__ __forceinline__ float bfhi(unsigned w) { return (float)__builtin_bit_cast(h16x2, w)[1]; }
__device__ __forceinline__ float wave_sum(float v) {
    v += __int_as_float(__builtin_amdgcn_ds_swizzle(__float_as_int(v), 0x041F));
    v += __int_as_float(__builtin_amdgcn_ds_swizzle(__float_as_int(v), 0x081F));
    v += __int_as_float(__builtin_amdgcn_ds_swizzle(__float_as_int(v), 0x101F));
    v += __int_as_float(__builtin_amdgcn_ds_swizzle(__float_as_int(v), 0x201F));
    v += __int_as_float(__builtin_amdgcn_ds_swizzle(__float_as_int(v), 0x401F));
    auto rr = __builtin_amdgcn_permlane32_swap(__float_as_uint(v), __float_as_uint(v), false, false);
    return __uint_as_float(rr[0]) + __uint_as_float(rr[1]);
}

__device__ __forceinline__ int lane_id_now() { int l; asm volatile("v_mbcnt_lo_u32_b32 %0, -1, 0\n\tv_mbcnt_hi_u32_b32 %0, -1, %0" : "=v"(l)); return l; }

#define XB_TMO      128
#define XB_XCNT(j)  (256  + 64 * (j))
#define XB_XSUB(j)  (1280 + 64 * (j))
#define XB_XGEN(j)  (2304 + 64 * (j))
#define XB_TOP      3328
#define XB_TOPGEN   3392
#define XCD_BAR_WORDS 3456
#define XB_SPIN_CAP (1u << 18)

__device__ __forceinline__ unsigned xb_ld(unsigned* p)              { return __hip_atomic_load(p, __ATOMIC_RELAXED, __HIP_MEMORY_SCOPE_AGENT); }
__device__ __forceinline__ unsigned xb_add(unsigned* p, unsigned v) { return __hip_atomic_fetch_add(p, v, __ATOMIC_RELAXED, __HIP_MEMORY_SCOPE_AGENT); }
__device__ __forceinline__ unsigned xb_xcc_id() { return (unsigned)__builtin_amdgcn_s_getreg((3 << 11) | 20) & 0xFu; }
#define XB_SPIN(cond, bar) do { unsigned _sp = 0; while (cond) { __builtin_amdgcn_s_sleep(1); \
    if ((++_sp & 255u) == 0u) { if (xb_ld(&(bar)[XB_TMO])) break; if (_sp > XB_SPIN_CAP) { atomicAdd(&(bar)[XB_TMO], 1u); break; } } } } while (0)

struct XcdBarrier {
    unsigned* bar; unsigned x;
    volatile LAS unsigned* st;
};

__device__ __forceinline__ XcdBarrier xcd_barrier_post(unsigned* bar, volatile LAS unsigned* st) {
    XcdBarrier b; b.bar = bar; b.x = xb_xcc_id(); b.st = st;
    if (threadIdx.x == 0) (void)xb_add(&bar[XB_XCNT(b.x)], 1u);
    return b;
}
__device__ __forceinline__ void xcd_barrier_complete(unsigned* bar, unsigned x, unsigned& nloc, unsigned& nx) {
    const unsigned G = gridDim.x * gridDim.y * gridDim.z;
    unsigned sum, cnt, mine, sp = 0u;
    for (;;) {
        sum = 0u; cnt = 0u; mine = 0u;
#pragma unroll
        for (unsigned j = 0; j < 16; ++j) { const unsigned c = xb_ld(&bar[XB_XCNT(j)]); sum += c; cnt += (c > 0u) ? 1u : 0u; mine = (j == x) ? c : mine; }
        if (sum == G) break;
        __builtin_amdgcn_s_sleep(1);
        if ((++sp & 255u) == 0u) { if (xb_ld(&bar[XB_TMO])) break; if (sp > XB_SPIN_CAP) { atomicAdd(&bar[XB_TMO], 1u); break; } }
    }
    nloc = mine > 0u ? mine : 1u; nx = cnt > 0u ? cnt : 1u;
}

__device__ __forceinline__ void xcd_barrier(const XcdBarrier& b) {
    asm volatile("s_waitcnt vmcnt(0)" ::: "memory");
    __syncthreads();
    if (threadIdx.x == 0) {
        unsigned* bar = b.bar;
        __builtin_amdgcn_s_waitcnt(0);
        unsigned nloc = b.st[0], nx = b.st[1];
        if (nloc == 0u) { xcd_barrier_complete(bar, b.x, nloc, nx); b.st[0] = nloc; b.st[1] = nx; }
        const unsigned old = xb_add(&bar[XB_XSUB(b.x)], 1u);
        const unsigned gen = old / nloc;
        if (old + 1u == (gen + 1u) * nloc) {
            __builtin_amdgcn_fence(__ATOMIC_RELEASE, "agent");
            asm volatile("s_waitcnt vmcnt(0)" ::: "memory");
            const unsigned og = xb_add(&bar[XB_TOP], 1u);
            const unsigned tg = og / nx;
            if (og + 1u == (tg + 1u) * nx) xb_add(&bar[XB_TOPGEN], 1u);
            else XB_SPIN(xb_ld(&bar[XB_TOPGEN]) == tg, bar);
            __builtin_amdgcn_fence(__ATOMIC_ACQUIRE, "agent");
            xb_add(&bar[XB_XGEN(b.x)], 1u);
            asm volatile("s_waitcnt vmcnt(0)" ::: "memory");
        } else {
            XB_SPIN(xb_ld(&bar[XB_XGEN(b.x)]) == gen, bar);
            __builtin_amdgcn_fence(__ATOMIC_ACQUIRE, "agent");
            asm volatile("s_waitcnt vmcnt(0)" ::: "memory");
        }
    }
    __syncthreads();
}


struct Frame {
    LAS unsigned char* lds;
    int tid, lane, wave, vcu, G;
    const float* in[23]; float* out; unsigned char* ws;
};
__constant__ double ROPE_INV[16] = {1.0, 0.5623413251903491, 0.31622776601683794, 0.1778279410038923, 0.1, 0.05623413251903491, 0.03162277660168379, 0.01778279410038923,
                                    0.01, 0.005623413251903491, 0.0031622776601683794, 0.0017782794100389228, 0.001, 0.0005623413251903491, 0.00031622776601683794, 0.00017782794100389227};

__device__ __forceinline__ void transpose_item(const float* W, int K, int N, bf16* WT, int k0, int n0, int drow0, const float* kscale, LAS float* scr, int lane) {
#pragma unroll 8
    for (int i = 0; i < 32; ++i) { const int kk = 2 * i + (lane >> 5); float v = W[(size_t)(k0 + kk) * N + n0 + (lane & 31)]; if (kscale) v *= kscale[k0 + kk]; scr[kk * 33 + (lane & 31)] = v; }
    LDS_WAIT(); asm volatile("" ::: "memory");
    const int c = lane & 7;
#pragma unroll
    for (int j = 0; j < 4; ++j) { const int n = (lane >> 3) + 8 * j; const LAS float* s = scr + (8 * c) * 33 + n;
        v4u o; o.x = pk2(s[0 * 33], s[1 * 33]); o.y = pk2(s[2 * 33], s[3 * 33]); o.z = pk2(s[4 * 33], s[5 * 33]); o.w = pk2(s[6 * 33], s[7 * 33]);
        *(GAS v4u*)(WT + (size_t)(drow0 + n) * K + k0 + 8 * c) = o; }
    LDS_WAIT(); asm volatile("" ::: "memory");
}
__device__ __forceinline__ int win_row(int n0) { return n0 < 384 ? n0 : (n0 < 640 ? 512 + (n0 - 384) : (n0 < 672 ? 384 + (n0 - 640) : 768 + (n0 - 672))); }
__device__ __forceinline__ int wfi_row(int n0) { const int g = n0 >= DFF ? 1 : 0, n = n0 - g * DFF; return (n >> 7) * 256 + g * 128 + (n & 127); }


__device__ __forceinline__ void convert_layer(Frame& F, const int l, bf16* wb, const int gw, const int nw, LAS float* scr) {
    constexpr int I_IN = (DM / 64) * (NIN / 32), I_QB = (QLORA / 64) * (768 / 32), I_KVB = (KVLORA / 64) * (1024 / 32), I_OA = (512 / 64) * (DM / 32), I_OB = (DM / 64) * (DM / 32), I_OUT = I_OB,
                  I_FI = (DM / 64) * (2 * DFF / 32), I_FO = (DFF / 64) * (DM / 32), I_L = I_IN + I_QB + I_KVB + I_OA + I_OB + I_OUT + I_FI + I_FO;
#pragma nounroll
    for (int it = gw; it < I_L; it += nw) {
        int r = it;
        if (r < I_IN) { const int nb = NIN / 32, kb = r / nb, n0 = (r % nb) * 32; transpose_item(F.in[7] + (size_t)l * DM * NIN, DM, NIN, wb + WO_IN, kb * 64, n0, win_row(n0), nullptr, scr, F.lane); continue; } r -= I_IN;
        if (r < I_QB) { const int nb = 768 / 32, kb = r / nb, n0 = (r % nb) * 32; transpose_item(F.in[10] + (size_t)l * QLORA * 768, QLORA, 768, wb + WO_QB, kb * 64, n0, (n0 / 96) * 128 + n0 % 96, F.in[8] + l * QLORA, scr, F.lane); continue; } r -= I_QB;
        if (r < I_KVB) { const int nb = 1024 / 32, kb = r / nb, n0 = (r % nb) * 32; transpose_item(F.in[11] + (size_t)l * KVLORA * 1024, KVLORA, 1024, wb + WO_KVB, kb * 64, n0, n0, F.in[9] + l * KVLORA, scr, F.lane); continue; } r -= I_KVB;
        if (r < I_OA) { const int nb = DM / 32, kb = r / nb, n0 = (r % nb) * 32; transpose_item(F.in[14] + (size_t)l * 512 * DM, 512, DM, wb + WO_OA, kb * 64, n0, n0, nullptr, scr, F.lane); continue; } r -= I_OA;
        if (r < I_OB) { const int nb = DM / 32, kb = r / nb, n0 = (r % nb) * 32; transpose_item(F.in[18] + (size_t)l * DM * DM, DM, DM, wb + WO_OB, kb * 64, n0, n0, nullptr, scr, F.lane); continue; } r -= I_OB;
        if (r < I_OUT) { const int nb = DM / 32, kb = r / nb, n0 = (r % nb) * 32; transpose_item(F.in[19] + (size_t)l * DM * DM, DM, DM, wb + WO_OUT, kb * 64, n0, n0, nullptr, scr, F.lane); continue; } r -= I_OUT;
        if (r < I_FI) { const int nb = 2 * DFF / 32, kb = r / nb, n0 = (r % nb) * 32; transpose_item(F.in[21] + (size_t)l * DM * 2 * DFF, DM, 2 * DFF, wb + WO_FI, kb * 64, n0, wfi_row(n0), nullptr, scr, F.lane); continue; } r -= I_FI;
        { const int nb = DM / 32, kb = r / nb, n0 = (r % nb) * 32; transpose_item(F.in[22] + (size_t)l * DFF * DM, DFF, DM, wb + WO_FO, kb * 64, n0, n0, nullptr, scr, F.lane); }
    }
    const int gt = gw * 64 + F.lane, NT = nw * 64;
    unsigned zz = 0u; asm volatile("" : "+v"(zz)); const v4u zero4 = {zz, zz, zz, zz};
#pragma nounroll
    for (int i = gt; i < 96 * (DM / 8); i += NT) *(GAS v4u*)(wb + WO_IN + (size_t)(416 + i / (DM / 8)) * DM + (i % (DM / 8)) * 8) = zero4;
#pragma nounroll
    for (int i = gt; i < 8 * 32 * (QLORA / 8); i += NT) { const int rw = i / (QLORA / 8);
        *(GAS v4u*)(wb + WO_QB + (size_t)((rw >> 5) * 128 + 96 + (rw & 31)) * QLORA + (i % (QLORA / 8)) * 8) = zero4; }
#pragma nounroll
    for (int i = gt; i < 8 * 128 * 128 / 4; i += NT) { const f32x4 v = *(const f32x4*)(F.in[16] + (size_t)l * 131072 + (size_t)i * 4);
        *(GAS v2u*)(wb + WO_S + (size_t)i * 4) = (v2u){pk2(v.x, v.y), pk2(v.z, v.w)}; }
}
__device__ __forceinline__ void pre0(Frame& F) {
    convert_layer(F, 0, (bf16*)(F.ws + WS_WB), F.vcu * NWAVES + F.wave, F.G * NWAVES, (LAS float*)(F.lds + F.wave * 16384));
    {
        const int gt = F.vcu * (NWAVES * 64) + F.tid, NT = F.G * NWAVES * 64;
        float* rc = (float*)(F.ws + WS_ROPE); float* rs = rc + 8192 * 16;
        for (int i = gt; i < 8192 * 16; i += NT) { const int pos = i >> 4, k = i & 15;
            double t = (double)pos * ROPE_INV[k] * 0.15915494309189535; t -= __builtin_rint(t);
            const float tf = (float)t; rc[i] = __builtin_amdgcn_cosf(tf); rs[i] = __builtin_amdgcn_sinf(tf); }
    }
    {
        LAS float* sv = (LAS float*)F.lds;
        constexpr int NCB = NMOD / 512, NITEM = NL * KSPLIT * NCB;
        for (int it = F.vcu; it < NITEM; it += F.G) {
            const int l = it / (KSPLIT * NCB), kc = (it / NCB) % KSPLIT, cb = it % NCB;
            __syncthreads();
            for (int i = F.tid; i < NB * 128; i += NWAVES * 64) { const int b = i >> 7, k = kc * 128 + (i & 127);
                const float c = b < 2 ? F.in[2][b * DM + k] : F.in[3][(b - 2) * DM + k]; sv[i] = c * __builtin_amdgcn_rcpf(1.0f + __expf(-c)); }
            __syncthreads();
            const int n = cb * 512 + F.tid; const float* w = F.in[4] + ((size_t)l * DM + kc * 128) * NMOD + n;
            float a[NB];
#pragma unroll
            for (int b = 0; b < NB; ++b) a[b] = 0.f;
#pragma unroll 8
            for (int k = 0; k < 128; ++k) { const float wv = w[(size_t)k * NMOD];
#pragma unroll
                for (int b = 0; b < NB; ++b) a[b] = fmaf(sv[b * 128 + k], wv, a[b]); }
            float* mp = (float*)(F.ws + WS_MODP) + ((size_t)(kc * NL + l) * NB) * NMOD + n;
#pragma unroll
            for (int b = 0; b < NB; ++b) mp[(size_t)b * NMOD] = a[b];
        }
        __syncthreads();
    }
}
__device__ __forceinline__ void pre1(Frame& F) {
    const int gt = F.vcu * (NWAVES * 64) + F.tid, NT = F.G * NWAVES * 64;
    const float* mp = (const float*)(F.ws + WS_MODP); float* mod = (float*)(F.ws + WS_MOD); float* av = (float*)(F.ws + WS_AV);
    for (int i = gt; i < NL * NB * NMOD; i += NT) { const int l = i / (NB * NMOD), b = (i / NMOD) % NB, n = i % NMOD, chunk = n >> 10, c = n & 1023;
        float s = F.in[5][l * NMOD + n];
#pragma unroll
        for (int kc = 0; kc < KSPLIT; ++kc) s += mp[(size_t)kc * NL * NB * NMOD + i];
        mod[i] = s;
        if (chunk == 1) av[((size_t)l * NB + b) * DM + c] = F.in[6][l * DM + c] * (1.0f + s);
        else if (chunk == 4) av[(size_t)NL * NB * DM + ((size_t)l * NB + b) * DM + c] = F.in[20][l * DM + c] * (1.0f + s); }
}
__device__ __forceinline__ void h0_init(Frame& F) {
    const int gw = F.vcu * NWAVES + F.wave, NGW = F.G * NWAVES;
    const float* av = (const float*)(F.ws + WS_AV); bf16* HH = (bf16*)(F.ws + WS_HH); float* ssx = (float*)(F.ws + WS_SSX);
#pragma nounroll
    for (int r = gw; r < TT; r += NGW) {
        const float* xrow = r < TG ? F.in[0] + (size_t)r * DM : F.in[1] + (size_t)(r - TG) * DM;
        const float* a = av + (size_t)pg8::seq_of_row(r) * DM;
        const GAS f32x4* xr = (const GAS f32x4*)xrow + F.lane;
        GAS v2u* o8 = (GAS v2u*)(HH + (size_t)r * DM) + F.lane; float s = 0.f;
#pragma unroll
        for (int j = 0; j < 4; ++j) { const f32x4 v = xr[64 * j]; const f32x4 aa = *(const f32x4*)(a + 4 * F.lane + 256 * j); const f32x4 y = v * aa;
            s += (v.x * v.x + v.y * v.y) + (v.z * v.z + v.w * v.w); o8[64 * j] = (v2u){pk2(y.x, y.y), pk2(y.z, y.w)}; }
        s = wave_sum(s);
        if (F.lane < 16) ssx[(size_t)r * 16 + F.lane] = F.lane == 0 ? s : 0.f;
    }
}
__device__ __forceinline__ void bias_gemv(Frame& F) {
    LAS float* shl = (LAS float*)F.lds;
    LAS float* part = (LAS float*)(F.lds + 49152);
    const float* MOD = (const float*)(F.ws + WS_MOD); float* BIAS = (float*)(F.ws + WS_BIAS);
    constexpr int NB_IN = NIN / 32, NB_FI = 2 * DFF / 32, NB_L = NB_IN + NB_FI, NITEM = NL * NB_L;
    const int col = F.lane & 31, kh = F.lane >> 5;
#pragma nounroll
    for (int it = F.vcu; it < NITEM; it += F.G) {
        const int l = it / NB_L, r = it % NB_L, which = r >= NB_IN ? 1 : 0, n0 = (which ? r - NB_IN : r) * 32;
        __syncthreads();
        for (int i = F.tid; i < NB * DM; i += NWAVES * 64) { const int b = i >> 10, k = i & 1023; shl[k * 12 + b] = MOD[((size_t)l * NB + b) * NMOD + (which ? 3 * DM : 0) + k]; }
        __syncthreads();
        const int N = which ? 2 * DFF : NIN; const float* W = (which ? F.in[21] + (size_t)l * DM * 2 * DFF : F.in[7] + (size_t)l * DM * NIN) + n0 + col;
        const int k0 = 128 * F.wave + 64 * kh;
        float a[NB];
#pragma unroll
        for (int b = 0; b < NB; ++b) a[b] = 0.f;
#pragma unroll 4
        for (int k = 0; k < 64; ++k) { const float wv = W[(size_t)(k0 + k) * N]; const LAS f32x4* sp = (const LAS f32x4*)(shl + (k0 + k) * 12); const f32x4 s0 = sp[0], s1 = sp[1], s2 = sp[2];
            a[0] = fmaf(s0[0], wv, a[0]); a[1] = fmaf(s0[1], wv, a[1]); a[2] = fmaf(s0[2], wv, a[2]); a[3] = fmaf(s0[3], wv, a[3]); a[4] = fmaf(s1[0], wv, a[4]);
            a[5] = fmaf(s1[1], wv, a[5]); a[6] = fmaf(s1[2], wv, a[6]); a[7] = fmaf(s1[3], wv, a[7]); a[8] = fmaf(s2[0], wv, a[8]); a[9] = fmaf(s2[1], wv, a[9]); }
#pragma unroll
        for (int b = 0; b < NB; ++b) part[((F.wave * 2 + kh) * NB + b) * 32 + col] = a[b];
        __syncthreads();
        if (F.tid < NB * 32) { const int b = F.tid >> 5, c = F.tid & 31; float s = 0.f;
#pragma unroll
            for (int j = 0; j < 16; ++j) s += part[(j * NB + b) * 32 + c];
            BIAS[((size_t)l * NB + b) * BIASW + (which ? 19 * 256 + wfi_row(n0) : win_row(n0)) + c] = s; }
    }
    for (int i = F.vcu * (NWAVES * 64) + F.tid; i < NL * NB * 96; i += F.G * NWAVES * 64) BIAS[(size_t)(i / 96) * BIASW + 416 + i % 96] = 0.f;
    __syncthreads();
}
struct SguLoads { v4u gv[4]; f32x4 ss[4]; bf16x8 wf[4]; v2u uu[8]; f32x4 sg[2][2]; float bias; };
__device__ __forceinline__ void sgu_mix(Frame& F, const bf16* GV, const float* SSG, const float* sg, const bf16* Ws  , const float* bs  , bf16* U, const bool do_store) {
    constexpr int VP = 136;
    LAS bf16* vT = (LAS bf16*)F.lds; LAS float* rq = (LAS float*)(F.lds + 128 * VP * 2);
    const int lane = F.lane, w = F.wave, tid = F.tid;
    const int NU = (TT / 128) * 8;
#define SGU_LOAD(L, it) do { const int ck_ = (it) >> 3, gi_ = (it) & 7; \
        _Pragma("unroll") for (int i = 0; i < 4; ++i) { const int q = lane + 64 * (i & 1), c8 = 8 * (w + 8 * (i >> 1)); L.gv[i] = *(const v4u*)(GV + (size_t)(ck_ * 128 + q) * DM + gi_ * 128 + c8); } \
        if (tid < 128) { _Pragma("unroll") for (int j = 0; j < 4; ++j) L.ss[j] = *(const f32x4*)(SSG + (size_t)(ck_ * 128 + tid) * 16 + 4 * j); } \
        { const int p_ = 16 * w + (lane & 15); \
          _Pragma("unroll") for (int ks = 0; ks < 4; ++ks) L.wf[ks] = *(const bf16x8*)(Ws + ((size_t)gi_ * 128 + p_) * 128 + 32 * ks + 8 * (lane >> 4)); \
          _Pragma("unroll") for (int cb = 0; cb < 8; ++cb) L.uu[cb] = *(const v2u*)(U + ((size_t)ck_ * 128 + p_) * DM + gi_ * 128 + 16 * cb + 4 * (lane >> 4)); \
          L.bias = bs[gi_ * 128 + p_]; } \
        _Pragma("unroll") for (int hf = 0; hf < 2; ++hf) { const int c8 = 8 * (w + 8 * hf); L.sg[hf][0] = *(const f32x4*)(sg + gi_ * 128 + c8); L.sg[hf][1] = *(const f32x4*)(sg + gi_ * 128 + c8 + 4); } } while (0)
#define SGU_RUN(L, it, LN, itn) do { const int ck_ = (it) >> 3, gi_ = (it) & 7; \
        __syncthreads(); \
        if (tid < 128) { const f32x4 a_ = L.ss[0], b_ = L.ss[1], c_ = L.ss[2], d_ = L.ss[3]; \
            const float s_ = ((a_[0] + a_[1]) + (a_[2] + a_[3])) + ((b_[0] + b_[1]) + (b_[2] + b_[3])) + ((c_[0] + c_[1]) + (c_[2] + c_[3])) + ((d_[0] + d_[1]) + (d_[2] + d_[3])); \
            rq[tid] = 1.0f / sqrtf(s_ * (1.0f / 1024.0f) + EPS); } \
        __syncthreads(); \
        { _Pragma("unroll") for (int i = 0; i < 4; ++i) { const int q = lane + 64 * (i & 1), c8 = 8 * (w + 8 * (i >> 1)); const v4u wv = L.gv[i]; const f32x4 g0 = L.sg[i >> 1][0], g1 = L.sg[i >> 1][1]; \
            const float gq[8] = {g0[0], g0[1], g0[2], g0[3], g1[0], g1[1], g1[2], g1[3]}; \
            const float x[8] = {bflo(wv.x), bfhi(wv.x), bflo(wv.y), bfhi(wv.y), bflo(wv.z), bfhi(wv.z), bflo(wv.w), bfhi(wv.w)}; const float r = rq[q]; \
            _Pragma("unroll") for (int j = 0; j < 8; ++j) vT[(c8 + j) * VP + q] = (bf16)f2bf(x[j] * r * gq[j]); } } \
        __syncthreads(); \
        if ((itn) < NU) SGU_LOAD(LN, itn);                           \
        f32x4 acc[8]; \
        _Pragma("unroll") for (int cb = 0; cb < 8; ++cb) acc[cb] = (f32x4){0.f, 0.f, 0.f, 0.f}; \
        _Pragma("unroll") for (int ks = 0; ks < 4; ++ks) { \
            _Pragma("unroll") for (int cb = 0; cb < 8; ++cb) { const bf16x8 afrag = *(const LAS bf16x8*)(vT + (16 * cb + (lane & 15)) * VP + 32 * ks + 8 * (lane >> 4)); \
                acc[cb] = __builtin_amdgcn_mfma_f32_16x16x32_f16(__builtin_bit_cast(h16x8, afrag), __builtin_bit_cast(h16x8, L.wf[ks]), acc[cb], 0, 0, 0); } } \
        { const int p_ = 16 * w + (lane & 15); const float bias = L.bias; \
          _Pragma("unroll") for (int cb = 0; cb < 8; ++cb) { bf16* up = U + ((size_t)ck_ * 128 + p_) * DM + gi_ * 128 + 16 * cb + 4 * (lane >> 4); const v2u uw = L.uu[cb]; \
            if (do_store) *(GAS v2u*)up = (v2u){pk2(bflo(uw.x) * (acc[cb][0] + bias), bfhi(uw.x) * (acc[cb][1] + bias)), pk2(bflo(uw.y) * (acc[cb][2] + bias), bfhi(uw.y) * (acc[cb][3] + bias))}; } } } while (0)
    SguLoads A, B;
    int it = F.vcu;
    if (it < NU) SGU_LOAD(A, it);
#pragma nounroll
    for (; it < NU; it += 2 * F.G) {
        SGU_RUN(A, it, B, it + F.G);
        if (it + F.G < NU) SGU_RUN(B, it + F.G, A, it + 2 * F.G);
    }
#undef SGU_LOAD
#undef SGU_RUN
    __syncthreads();
}

__device__ __forceinline__ void attn_phase(Frame& F, const bf16* Q, const bf16* K, const bf16* V, bf16* O) {
#pragma nounroll
    for (int i = 0; i < 4; ++i) {
        const int u = F.vcu + (i & 1) * 256;
        int st, sl, h, qb;
        if (i < 2) { const int bh = u >> 5; qb = u & 31; st = (bh >> 3) * 8192; sl = 8192; h = bh & 7; }
        else       { const int bh = u >> 3; qb = u & 7; st = TG + (bh >> 3) * 2048; sl = 2048; h = bh & 7; }
        const size_t hb = (size_t)st * 8 + (size_t)h * sl;
        att2::attn_unit<8>(F.wave, Q + (hb + qb * 256) * 96, K + hb * 96, V + hb * 64, O + ((size_t)st + qb * 256) * 512 + h * 64, sl / 64, (char*)F.lds);
    }
}

constexpr int NPRE = 3, NPH = 7, NSTEPS = NPRE + NL * NPH;
struct Args { const float* in[23]; float* out; unsigned char* ws; int s_lo, s_hi; };
__global__ void __launch_bounds__(NWAVES * 64, 2) mk_fwd(Args args) {
    extern __shared__ __attribute__((aligned(16))) unsigned char lds[];
    Frame F;
    F.lds = (LAS unsigned char*)lds;
    F.tid = threadIdx.x; F.lane = F.tid & 63; F.wave = __builtin_amdgcn_readfirstlane(F.tid >> 6);
    F.G = gridDim.x; { const int bx = blockIdx.x; F.vcu = (F.G % 8 == 0) ? (bx % 8) * (F.G / 8) + bx / 8 : bx; }
#pragma unroll
    for (int i = 0; i < 23; ++i) F.in[i] = args.in[i];
    F.out = args.out; F.ws = args.ws;
    unsigned* ctl = (unsigned*)(F.ws + WS_CTL);
    for (int u = F.tid; u < (LDS_BYTES - LDSCTL_OFF) / 4; u += NWAVES * 64) ((LAS unsigned*)(F.lds + LDSCTL_OFF))[u] = 0u;
    __syncthreads();
    const int s_lo = args.s_lo, s_hi = args.s_hi;
    XcdBarrier bar; bar.bar = ctl + CW_BAR; bar.x = 0; bar.st = nullptr;
    if (s_hi - s_lo > 1) bar = xcd_barrier_post(ctl + CW_BAR, (volatile LAS unsigned*)(F.lds + MISC_OFF) + 8);
    int step = 0;
#define RUN() (s_lo <= step && step < s_hi)
#define SEAM() do { if (step + 1 < s_hi) xcd_barrier(bar); } while (0)
    if (RUN()) { pre0(F); SEAM(); } ++step;
    if (RUN()) { pre1(F); SEAM(); } ++step;
    if (RUN()) { h0_init(F); bias_gemv(F); SEAM(); } ++step;
    for (int l = 0; l < NL; ++l) {
#define CTX() int l_ = l; asm volatile("" : "+s"(l_)); Frame P = F; P.lane = lane_id_now(); P.tid = P.wave * 64 + P.lane; \
        const bf16* wb = (const bf16*)(F.ws + WS_WB + (size_t)(l_ & 1) * WB_LAYER); const float* modl = (const float*)(F.ws + WS_MOD) + (size_t)l_ * NB * NMOD; \
        const float* biasl = (const float*)(F.ws + WS_BIAS) + (size_t)l_ * NB * BIASW; float* ssx = (float*)(F.ws + WS_SSX); bf16* HH = (bf16*)(F.ws + WS_HH); bf16* Qb = HH; bf16* x16 = (bf16*)(F.ws + WS_X16); \
        const float* av1n = (const float*)(F.ws + WS_AV) + (size_t)(l_ + 1) * NB * DM; const float* av2 = (const float*)(F.ws + WS_AV) + (size_t)NL * NB * DM + (size_t)l_ * NB * DM; \
        unsigned char* dsc = (unsigned char*)F.out; bf16* Kb = (bf16*)(dsc + DO_K); bf16* Vb = (bf16*)(dsc + DO_V); bf16* LAT = (bf16*)(dsc + DO_LAT); bf16* Ob = LAT; \
        bf16* U = (bf16*)(F.ws + WS_U); bf16* GV = (bf16*)(F.ws + WS_GV); bf16* TMP = GV; bf16* SGA = (bf16*)(F.ws + WS_SGA); bf16* SGB = (bf16*)(F.ws + WS_SGB); \
        float* ssl = (float*)(F.ws + WS_SSL); float* ssg = (float*)(F.ws + WS_SSG); const float* rc0 = (const float*)(F.ws + WS_ROPE); const float* rs0 = rc0 + 8192 * 16; \
        (void)P; (void)wb; (void)modl; (void)biasl; (void)ssx; (void)HH; (void)Qb; (void)x16; (void)av1n; (void)av2; (void)Kb; (void)Vb; (void)LAT; (void)Ob; (void)U; (void)GV; (void)TMP; (void)SGA; (void)SGB; (void)ssl; (void)ssg; (void)rc0; (void)rs0
        if (RUN()) { CTX(); pg8::Gemm g{HH, wb + WO_IN, TT, NINP, DM, DM, DM}; pg8::StaticOrder S; S.init(TT, NINP, F.G, (int)blockIdx.x);
            LAS float* rtab = (LAS float*)(F.lds + RTAB_OFF); pg8::build_rstd_table(rtab, ssx, S, P.tid);
            pg8::EpiProj E{LAT, U, GV, SGA, SGB, rtab, biasl, 0, ssl, ssg};
            pg8::gemm_phase<DM, DM, DM, pg8::EpiProj, pg8::StaticOrder, true, true>(F.lds, g, S, E, F.wave);
            if (l_ + 1 < NL && (int)blockIdx.x >= 128) { __syncthreads(); convert_layer(P, l_ + 1, (bf16*)(F.ws + WS_WB + (size_t)((l_ + 1) & 1) * WB_LAYER), ((int)blockIdx.x - 128) * NWAVES + P.wave, (F.G - 128) * NWAVES, (LAS float*)(F.lds + P.wave * 16384)); }
            SEAM(); } ++step;
        if (RUN()) { CTX();
#pragma nounroll
            for (int hf = 0; hf < 2; ++hf) {
                { pg8::Gemm g{LAT, wb + WO_QB, TT, 1024, QLORA, LATW, QLORA}; pg8::StaticOrder S; S.init(TT, 1024, F.G, (int)blockIdx.x); S.i0 = hf; S.i1 = hf + 1;
                  pg8::EpiQ E{Qb, ssl, F.in[12] + l_ * 96, rc0, rs0, att2::QSCALE};
                  pg8::gemm_phase<QLORA, LATW, QLORA, pg8::EpiQ, pg8::StaticOrder, true, true>(F.lds, g, S, E, F.wave); }
                { pg8::Gemm g{LAT + 512, wb + WO_KVB, TT, 1024, KVLORA, LATW, KVLORA}; pg8::StaticOrder S; S.init(TT, 1024, F.G, (int)blockIdx.x); S.i0 = hf; S.i1 = hf + 1;
                  pg8::EpiKV E{Kb, Vb, LAT, LATW, ssl, F.in[13] + l_ * 96, rc0, rs0};
                  pg8::gemm_phase<KVLORA, LATW, KVLORA, pg8::EpiKV, pg8::StaticOrder, true, true>(F.lds, g, S, E, F.wave); } }
            sgu_mix(P, GV, ssg, F.in[15] + l_ * DM, wb + WO_S, F.in[17] + l_ * 1024, U, true);
            SEAM(); } ++step;
        if (RUN()) { CTX(); attn_phase(P, Qb, Kb, Vb, Ob); SEAM(); } ++step;
        if (RUN()) { CTX();
            { pg8::Gemm g{Ob, wb + WO_OA, TT, DM, 512, 512, 512}; pg8::StaticOrder S; S.init(TT, DM, F.G, (int)blockIdx.x); pg8::EpiGate<false> E{SGA, nullptr, TMP, DM};
              pg8::gemm_phase<512, 512, 512, pg8::EpiGate<false>, pg8::StaticOrder, true, true>(F.lds, g, S, E, F.wave); }
            { pg8::Gemm g{U, wb + WO_OB, TT, DM, DM, DM, DM}; pg8::StaticOrder S; S.init(TT, DM, F.G, (int)blockIdx.x); pg8::EpiGate<true> E{SGB, TMP, TMP, DM};
              pg8::gemm_phase<DM, DM, DM, pg8::EpiGate<true>, pg8::StaticOrder, true, true>(F.lds, g, S, E, F.wave); }
            SEAM(); } ++step;
        if (RUN()) { CTX(); pg8::Gemm g{TMP, wb + WO_OUT, TT, DM, DM, DM, DM}; pg8::StaticOrder S; S.init(TT, DM, F.G, (int)blockIdx.x);
            pg8::EpiRes E{l_ == 0 ? F.in[0] : nullptr, F.in[1], x16, nullptr, x16, modl + 2 * DM, NMOD, av2, HH, ssx, 0};
            pg8::gemm_phase<DM, DM, DM, pg8::EpiRes, pg8::StaticOrder, true, true>(F.lds, g, S, E, F.wave); SEAM(); } ++step;
        if (RUN()) { CTX(); pg8::Gemm g{HH, wb + WO_FI, TT, 2 * DFF, DM, DM, DM}; pg8::StaticOrder S; S.init(TT, 2 * DFF, F.G, (int)blockIdx.x);
            LAS float* rtab = (LAS float*)(F.lds + RTAB_OFF); pg8::build_rstd_table(rtab, ssx, S, P.tid);
            pg8::EpiSwiglu E{(bf16*)(F.ws + WS_ACT), DFF, rtab, biasl, 0};
            pg8::gemm_phase<DM, DM, DM, pg8::EpiSwiglu, pg8::StaticOrder, true, true>(F.lds, g, S, E, F.wave); SEAM(); } ++step;
        if (RUN()) { CTX(); pg8::Gemm g{(const bf16*)(F.ws + WS_ACT), wb + WO_FO, TT, DM, DFF, DFF, DFF}; pg8::StaticOrder S; S.init(TT, DM, F.G, (int)blockIdx.x);
            pg8::EpiRes E{nullptr, nullptr, x16, l_ + 1 < NL ? nullptr : F.out, x16, modl + 5 * DM, NMOD, av1n, l_ + 1 < NL ? HH : nullptr, ssx, 0};
            pg8::gemm_phase<DFF, DFF, DFF, pg8::EpiRes, pg8::StaticOrder, true, true>(F.lds, g, S, E, F.wave); SEAM(); } ++step;
#undef CTX
    }
#undef RUN
#undef SEAM
}

extern "C" void kernel_launch(void* const* d_in, const int* in_sizes, int n_in, void* d_out, int out_size, void* d_ws, size_t ws_size, hipStream_t stream) {
    static int grid = 0;
    if (grid == 0) {
        if (n_in != 23 || out_size != NGRP * TG * DM || ws_size < WS_END) { fprintf(stderr, "kernel_launch: unexpected shapes (n_in %d, out %d, ws %zu; need ws >= %zu); nothing launched\n", n_in, out_size, ws_size, (size_t)WS_END); grid = -1; return; }
        int dev = 0, cus = 0, per_cu = 0;
        if (hipGetDevice(&dev) != hipSuccess || hipDeviceGetAttribute(&cus, hipDeviceAttributeMultiprocessorCount, dev) != hipSuccess) { grid = -1; return; }
        if (hipFuncSetAttribute((const void*)mk_fwd, hipFuncAttributeMaxDynamicSharedMemorySize, LDS_BYTES) != hipSuccess) { fprintf(stderr, "kernel_launch: hipFuncSetAttribute failed\n"); grid = -1; return; }
        if (hipOccupancyMaxActiveBlocksPerMultiprocessor(&per_cu, (const void*)mk_fwd, NWAVES * 64, LDS_BYTES) != hipSuccess || per_cu < 1) { fprintf(stderr, "kernel_launch: occupancy query reports %d\n", per_cu); }
        (void)hipGetLastError();
        if (cus < 256) { fprintf(stderr, "kernel_launch: built for a 256-CU device (the fused q / kv epilogues need one 256 x 256 unit per workgroup), found %d CUs; nothing launched\n", cus); grid = -1; return; }
        grid = 256;
    }
    if (grid < 0) return;
    if (hipMemsetAsync((char*)d_ws + WS_CTL, 0, CTL_ZERO_BYTES, stream) != hipSuccess) return;
    Args a{};
    for (int i = 0; i < 23; ++i) a.in[i] = (const float*)d_in[i];
    a.out = (float*)d_out; a.ws = (unsigned char*)d_ws;
#if MK_ONE_LAUNCH
    a.s_lo = 0; a.s_hi = NSTEPS;
    hipLaunchKernelGGL(mk_fwd, dim3(grid), dim3(NWAVES * 64), LDS_BYTES, stream, a);
#else
    for (int s = 0; s < NSTEPS; ++s) { a.s_lo = s; a.s_hi = s + 1; hipLaunchKernelGGL(mk_fwd, dim3(grid), dim3(NWAVES * 64), LDS_BYTES, stream, a); }
#endif
    const hipError_t le = hipPeekAtLastError();
    if (le != hipSuccess) fprintf(stderr, "kernel_launch: launch failed: %s\n", hipGetErrorName(le));
}
```

```cpp
#include <hip/hip_runtime.h>
#include <cstdio>
#include <cstdint>
namespace pg8 {
#define PG8_LAS __attribute__((address_space(3)))
typedef unsigned short bf16_t;
typedef _Float16 bf16x8 __attribute__((ext_vector_type(8)));
typedef float f32x4 __attribute__((ext_vector_type(4)));
typedef unsigned u32x4 __attribute__((ext_vector_type(4)));
constexpr int BM = 256, BK = 64, HALF = 128, HTB = HALF * BK * 2  , STAGE_BYTES = 8 * HTB, NXCD = 8, WGM = 8;

__host__ __device__ __forceinline__ int lds_byte(int r, int c) { const int st = (r >> 4) * 2 + (c >> 5), rr = r & 15, cc = c & 31, ob = rr * 64 + cc * 2; return st * 1024 + (ob ^ (((ob >> 9) & 1) << 5)); }
__host__ __device__ __forceinline__ void stage_rc(int b, int& R, int& C) { const int st = b / 1024, sb = b % 1024, swz = sb ^ (((sb >> 9) & 1) << 5); R = (st >> 1) * 16 + swz / 64; C = (st & 1) * 32 + (swz % 64) / 2; }
__host__ __device__ __forceinline__ int perm32(int rho) { const int n = rho >> 4, i = rho & 15; return 8 * (i >> 2) + 4 * n + (i & 3); }

struct Unit { int pm, pn, idx; };
struct Gemm { const bf16_t* A; const bf16_t* Bt; int M, N, K, lda, ldb; };

struct StaticOrder {
    int nM, nN, nwg, G, c, i0 = 0, i1 = 1 << 20;
    __host__ __device__ void init(int M, int N, int G_, int c_) { nM = M / BM; nN = N / BM; nwg = nM * nN; G = G_; c = c_; }
    __host__ __device__ bool next(int i, Unit& u) const {
        if (i + i0 >= i1) return false;
        const long L = (long)(i + i0) * G + c; if (L >= nwg) return false;
        int wgid = (int)L; { const int q = nwg / NXCD, r = nwg % NXCD, xcd = wgid % NXCD, off = wgid / NXCD; wgid = (xcd < r ? xcd * (q + 1) : r * (q + 1) + (xcd - r) * q) + off; }
        const int nig = WGM * nN, gid = wgid / nig, fm = gid * WGM, gsz = (nM - fm) < WGM ? (nM - fm) : WGM;
        u.pm = fm + ((wgid % nig) % gsz); u.pn = (wgid % nig) / gsz; u.idx = i; return true;
    }
    __device__ __forceinline__ void a_ready(const Unit&) const {}
    __device__ __forceinline__ void done(const Unit&) const {}
};

__device__ __forceinline__ unsigned cvt_pk_bf16(float lo, float hi) { unsigned r; asm volatile("v_cvt_pk_f16_f32 %0, %1, %2" : "=v"(r) : "v"(lo), "v"(hi)); return r; }
typedef float f32x2 __attribute__((ext_vector_type(2)));

typedef _Float16 h16x2 __attribute__((ext_vector_type(2)));
__device__ __forceinline__ float bf_lo(unsigned w) { return (float)__builtin_bit_cast(h16x2, w)[0]; }
__device__ __forceinline__ float bf_hi(unsigned w) { return (float)__builtin_bit_cast(h16x2, w)[1]; }
__device__ __forceinline__ float fast_sigmoid(float x) { return __builtin_amdgcn_rcpf(1.0f + __builtin_amdgcn_exp2f(x * -1.4426950408889634f)); }
__device__ __forceinline__ float gelu_tanh(float x) { const float y = x * (0.7978845608028654f + 0.035677408136300125f * x * x); return x * __builtin_amdgcn_rcpf(1.0f + __builtin_amdgcn_exp2f(y * -2.8853900817779268f)); }
#ifndef PG8_WT
#define PG8_WT 0
#endif
__device__ __forceinline__ void st16(bf16_t* base, size_t elem_off, const u32x4 v) {
#if PG8_WT
    __amdgpu_buffer_rsrc_t r = __builtin_amdgcn_make_buffer_rsrc((void*)base, 0, 0x7FFFFFFF, 0x00020000);
    __builtin_amdgcn_raw_buffer_store_b128(v, r, (unsigned)(elem_off * 2), 0, 16);
#else
    *(u32x4*)(base + elem_off) = v;
#endif
}
__device__ __forceinline__ u32x4 pack8(const f32x4 v0, const f32x4 v1) { u32x4 w; w.x = cvt_pk_bf16(v0[0], v0[1]); w.y = cvt_pk_bf16(v0[2], v0[3]); w.z = cvt_pk_bf16(v1[0], v1[1]); w.w = cvt_pk_bf16(v1[2], v1[3]); return w; }


__device__ __forceinline__ float row_rstd16(const float* slots, float inv_n, float eps) {
    const f32x4 a = *(const f32x4*)(slots), b = *(const f32x4*)(slots + 4), c = *(const f32x4*)(slots + 8), d = *(const f32x4*)(slots + 12);
    const float s = ((a[0] + a[1]) + (a[2] + a[3])) + ((b[0] + b[1]) + (b[2] + b[3])) + ((c[0] + c[1]) + (c[2] + c[3])) + ((d[0] + d[1]) + (d[2] + d[3]));
    return 1.0f / sqrtf(s * inv_n + eps);
}
template <class Sched> __device__ __forceinline__ void build_rstd_table(PG8_LAS float* tab, const float* slots, const Sched& S, int tid) {
    int nr = 0; { Unit u; while (nr < 12 && S.next(nr, u)) ++nr; }
    for (int idx = tid; idx < nr * 256; idx += 512) { Unit u; S.next(idx >> 8, u); tab[idx] = row_rstd16(slots + ((size_t)u.pm * BM + (idx & 255)) * 16, 1.0f / 1024.0f, 1e-6f); }
    __syncthreads();
}
__device__ __forceinline__ float sum_fq(float v) {
    v += __int_as_float(__builtin_amdgcn_ds_swizzle(__float_as_int(v), 0x401F));
    auto rr = __builtin_amdgcn_permlane32_swap(__float_as_uint(v), __float_as_uint(v), false, false);
    return __uint_as_float(rr[0]) + __uint_as_float(rr[1]);
}
__device__ __forceinline__ int seq_of_row(int r) { return r < 16384 ? (r >> 13) : 2 + ((r - 16384) >> 11); }

struct EpiPlain {
    static constexpr bool PERM = true, AFTER_DRAIN = false;
    bf16_t* O; int ldc;
    __device__ __forceinline__ void operator()(const f32x4 (&acc)[2][2][4][2], const Unit& u, int wr, int wc, int fr, int fq) const {
        const int row0 = u.pm * BM + wr * 64 + fr, col0 = u.pn * BM + wc * 32 + 8 * fq;
#pragma unroll
        for (int ai = 0; ai < 2; ++ai)
#pragma unroll
            for (int m = 0; m < 4; ++m) { const size_t roff = (size_t)(row0 + ai * HALF + m * 16) * ldc + col0;
#pragma unroll
                for (int bj = 0; bj < 2; ++bj) st16(O, roff + bj * HALF, pack8(acc[ai][bj][m][0], acc[ai][bj][m][1])); }
    }
};
struct EpiProj {
    static constexpr bool PERM = true, AFTER_DRAIN = false;
    bf16_t *LAT, *U, *GV, *SGA, *SGB;
    const PG8_LAS float* rtab;
    const float* bias;
    int row_base;
    float* ssl;
    float* ssg;
    __device__ __forceinline__ void operator()(const f32x4 (&acc)[2][2][4][2], const Unit& u, int wr, int wc, int fr, int fq) const {
        const int pn = u.pn; bf16_t* base; int ldc, colt, act;
        float* sp = nullptr; int slot = 0;
        if (pn == 0) { sp = ssl; slot = wc; } else if (pn == 1) { sp = ssl; slot = 4 + wc; } else if (pn == 2) { sp = ssl; slot = 8 + wc; } else if (pn >= 7 && pn < 11) { sp = ssg; slot = 4 * (pn - 7) + wc; }
        if (pn < 3) { base = LAT; ldc = 768; colt = pn * BM; act = 0; }
        else if (pn < 7) { base = U; ldc = 1024; colt = (pn - 3) * BM; act = 1; }
        else if (pn < 11) { base = GV; ldc = 1024; colt = (pn - 7) * BM; act = 1; }
        else if (pn < 15) { base = SGA; ldc = 1024; colt = (pn - 11) * BM; act = 2; }
        else { base = SGB; ldc = 1024; colt = (pn - 15) * BM; act = 2; }
        const int row0 = u.pm * BM + wr * 64 + fr, col0 = colt + wc * 32 + 8 * fq;
        const float* bp = bias + (size_t)seq_of_row(row_base + u.pm * BM) * (41 * 256) + pn * BM + wc * 32 + 8 * fq;
        f32x4 bv[2][2];
#pragma unroll
        for (int bj = 0; bj < 2; ++bj)
#pragma unroll
            for (int n = 0; n < 2; ++n) bv[bj][n] = *(const f32x4*)(bp + bj * HALF + 4 * n);
#pragma unroll
        for (int ai = 0; ai < 2; ++ai)
#pragma unroll
            for (int m = 0; m < 4; ++m) { const int row = row0 + ai * HALF + m * 16; const size_t roff = (size_t)row * ldc + col0;
                const float rs = rtab[u.idx * 256 + (row - u.pm * BM)]; float ss = 0.f;
#pragma unroll
                for (int bj = 0; bj < 2; ++bj) { f32x4 v0 = acc[ai][bj][m][0] * rs + bv[bj][0], v1 = acc[ai][bj][m][1] * rs + bv[bj][1];
                    if (act == 1) {
#pragma unroll
                        for (int j = 0; j < 4; ++j) { v0[j] = gelu_tanh(v0[j]); v1[j] = gelu_tanh(v1[j]); } }
                    else if (act == 2) {
#pragma unroll
                        for (int j = 0; j < 4; ++j) { v0[j] = fast_sigmoid(v0[j]); v1[j] = fast_sigmoid(v1[j]); } }
                    if (bj == 0 || pn != 1) ss += ((v0[0] * v0[0] + v0[1] * v0[1]) + (v0[2] * v0[2] + v0[3] * v0[3])) + ((v1[0] * v1[0] + v1[1] * v1[1]) + (v1[2] * v1[2] + v1[3] * v1[3]));
                    st16(base, roff + bj * HALF, pack8(v0, v1)); }
                if (sp) { ss = sum_fq(ss); if (fq == 0) sp[(size_t)row * 16 + slot] = ss; } }
    }
};
template <bool ADD> struct EpiGate {
    static constexpr bool PERM = true, AFTER_DRAIN = false;
    const bf16_t* G; const bf16_t* T; bf16_t* O; int ldc;
    __device__ __forceinline__ void operator()(const f32x4 (&acc)[2][2][4][2], const Unit& u, int wr, int wc, int fr, int fq) const {
        const int row0 = u.pm * BM + wr * 64 + fr, col0 = u.pn * BM + wc * 32 + 8 * fq;
#pragma unroll
        for (int am = 0; am < 2; ++am) { const int ai = am;
            u32x4 gq[4][2], tq[4][2];
#pragma unroll
            for (int m = 0; m < 4; ++m) { const size_t off = (size_t)(row0 + ai * HALF + m * 16) * ldc + col0;
#pragma unroll
                for (int bj = 0; bj < 2; ++bj) { gq[m][bj] = *(const u32x4*)(G + off + bj * HALF); if (ADD) tq[m][bj] = *(const u32x4*)(T + off + bj * HALF); } }
            asm volatile("" ::: "memory");
#pragma unroll
            for (int m = 0; m < 4; ++m) { const size_t off = (size_t)(row0 + ai * HALF + m * 16) * ldc + col0;
#pragma unroll
                for (int bj = 0; bj < 2; ++bj) { f32x4 v0 = acc[ai][bj][m][0], v1 = acc[ai][bj][m][1];
                    const u32x4 g = gq[m][bj];
                    v0[0] *= bf_lo(g.x); v0[1] *= bf_hi(g.x); v0[2] *= bf_lo(g.y); v0[3] *= bf_hi(g.y); v1[0] *= bf_lo(g.z); v1[1] *= bf_hi(g.z); v1[2] *= bf_lo(g.w); v1[3] *= bf_hi(g.w);
                    if (ADD) { const u32x4 t = tq[m][bj];
                        v0[0] += bf_lo(t.x); v0[1] += bf_hi(t.x); v0[2] += bf_lo(t.y); v0[3] += bf_hi(t.y); v1[0] += bf_lo(t.z); v1[1] += bf_hi(t.z); v1[2] += bf_lo(t.w); v1[3] += bf_hi(t.w); }
                    st16(O, off + bj * HALF, pack8(v0, v1)); } }
            asm volatile("" ::: "memory"); }
    }
};
struct EpiRes {
    static constexpr bool PERM = true, AFTER_DRAIN = false;
    const float* XI32; const bf16_t* XI16; float* XO32; bf16_t* XO16; const float* gate; int gld; const float* av; bf16_t* HO; float* SS; int row_base;
    __device__ __forceinline__ void operator()(const f32x4 (&acc)[2][2][4][2], const Unit& u, int wr, int wc, int fr, int fq) const {
        const int row0 = u.pm * BM + wr * 64 + fr, col0 = u.pn * BM + wc * 32 + 8 * fq;
        const int sq = seq_of_row(row_base + u.pm * BM);
        const float* gv = gate + (size_t)sq * gld + col0;
        f32x4 g[2][2], a[2][2];
#pragma unroll
        for (int bj = 0; bj < 2; ++bj)
#pragma unroll
            for (int n = 0; n < 2; ++n) { g[bj][n] = *(const f32x4*)(gv + bj * HALF + 4 * n); a[bj][n] = HO ? *(const f32x4*)(av + (size_t)sq * 1024 + col0 + bj * HALF + 4 * n) : (f32x4){0.f, 0.f, 0.f, 0.f}; }
#pragma unroll
        for (int am = 0; am < 4; ++am) { const int ai = am >> 1, m0 = (am & 1) * 2;
            f32x4 xq[2][2][2];
            if (XI32) {
#pragma unroll
                for (int mm = 0; mm < 2; ++mm) { const size_t off = (size_t)(row0 + ai * HALF + (m0 + mm) * 16) * 1024 + col0;
#pragma unroll
                    for (int bj = 0; bj < 2; ++bj)
#pragma unroll
                        for (int n = 0; n < 2; ++n) xq[mm][bj][n] = *(const f32x4*)(XI32 + off + bj * HALF + 4 * n); }
            } else {
                u32x4 xh[2][2];
#pragma unroll
                for (int mm = 0; mm < 2; ++mm) { const size_t off = (size_t)(row0 + ai * HALF + (m0 + mm) * 16) * 1024 + col0;
#pragma unroll
                    for (int bj = 0; bj < 2; ++bj) xh[mm][bj] = *(const u32x4*)(XI16 + off + bj * HALF); }
#pragma unroll
                for (int mm = 0; mm < 2; ++mm)
#pragma unroll
                    for (int bj = 0; bj < 2; ++bj) { const u32x4 w = xh[mm][bj]; xq[mm][bj][0] = (f32x4){bf_lo(w.x), bf_hi(w.x), bf_lo(w.y), bf_hi(w.y)}; xq[mm][bj][1] = (f32x4){bf_lo(w.z), bf_hi(w.z), bf_lo(w.w), bf_hi(w.w)}; }
            }
            asm volatile("" ::: "memory");
#pragma unroll
            for (int mm = 0; mm < 2; ++mm) { const int m = m0 + mm; const int row = row0 + ai * HALF + m * 16; const size_t off = (size_t)row * 1024 + col0; float ss = 0.f;
#pragma unroll
                for (int bj = 0; bj < 2; ++bj) { f32x4 x[2];
#pragma unroll
                    for (int n = 0; n < 2; ++n) { x[n] = xq[mm][bj][n] + g[bj][n] * acc[ai][bj][m][n];
                        ss += (x[n][0] * x[n][0] + x[n][1] * x[n][1]) + (x[n][2] * x[n][2] + x[n][3] * x[n][3]); }
                    if (XO32) { *(f32x4*)(XO32 + off + bj * HALF) = x[0]; *(f32x4*)(XO32 + off + bj * HALF + 4) = x[1]; }
                    else st16(XO16, off + bj * HALF, pack8(x[0], x[1]));
                    if (HO) st16(HO, off + bj * HALF, pack8(x[0] * a[bj][0], x[1] * a[bj][1])); }
                if (HO) { ss = sum_fq(ss); if (fq == 0) SS[(size_t)row * 16 + u.pn * 4 + wc] = ss; } }
            asm volatile("" ::: "memory"); }
    }
};
struct EpiSwiglu {
    static constexpr bool PERM = true, AFTER_DRAIN = false;
    bf16_t* O; int ldc; const PG8_LAS float* rtab; const float* bias  ; int row_base;
    __device__ __forceinline__ void operator()(const f32x4 (&acc)[2][2][4][2], const Unit& u, int wr, int wc, int fr, int fq) const {
        const int row0 = u.pm * BM + wr * 64 + fr, col0 = u.pn * HALF + wc * 32 + 8 * fq;
        const float* bp = bias + (size_t)seq_of_row(row_base + u.pm * BM) * (41 * 256) + (19 + u.pn) * BM + wc * 32 + 8 * fq;
        f32x4 bv[2][2];
#pragma unroll
        for (int bj = 0; bj < 2; ++bj)
#pragma unroll
            for (int n = 0; n < 2; ++n) bv[bj][n] = *(const f32x4*)(bp + bj * HALF + 4 * n);
#pragma unroll
        for (int ai = 0; ai < 2; ++ai)
#pragma unroll
            for (int m = 0; m < 4; ++m) { const int row = row0 + ai * HALF + m * 16; f32x4 o[2];
                const float rs = rtab[u.idx * 256 + (row - u.pm * BM)];
#pragma unroll
                for (int n = 0; n < 2; ++n)
#pragma unroll
                    for (int j = 0; j < 4; ++j) { const float up = acc[ai][0][m][n][j] * rs + bv[0][n][j], gt = acc[ai][1][m][n][j] * rs + bv[1][n][j]; o[n][j] = up * gt * fast_sigmoid(gt); }
                st16(O, (size_t)row * ldc + col0, pack8(o[0], o[1])); }
    }
};
__device__ __forceinline__ float bf_lo2(unsigned w) { return bf_lo(w); }
__device__ __forceinline__ void stage_tile_f16(const f32x4 (&acc)[2][2][4][2], PG8_LAS unsigned char* lds, int wr, int wc, int fr, int fq) {
#pragma unroll
    for (int ai = 0; ai < 2; ++ai)
#pragma unroll
        for (int m = 0; m < 4; ++m) { const int row = ai * HALF + wr * 64 + m * 16 + fr;
#pragma unroll
            for (int bj = 0; bj < 2; ++bj) { const int chunk = bj * 16 + wc * 4 + fq;
                *(PG8_LAS u32x4*)(lds + row * 512 + ((chunk ^ (row & 31)) << 4)) = pack8(acc[ai][bj][m][0], acc[ai][bj][m][1]); } }
    asm volatile("s_waitcnt lgkmcnt(0)" ::: "memory"); __builtin_amdgcn_s_barrier(); asm volatile("" ::: "memory");
}
__device__ __forceinline__ u32x4 tile_chunk(const PG8_LAS unsigned char* lds, int row, int chunk) { return *(const PG8_LAS u32x4*)(lds + row * 512 + ((chunk ^ (row & 31)) << 4)); }
__device__ __forceinline__ void unpack8h(const u32x4 w, float (&o)[8]) { o[0] = bf_lo(w.x); o[1] = bf_hi(w.x); o[2] = bf_lo(w.y); o[3] = bf_hi(w.y); o[4] = bf_lo(w.z); o[5] = bf_hi(w.z); o[6] = bf_lo(w.w); o[7] = bf_hi(w.w); }
__device__ __forceinline__ u32x4 pack8h(const float (&x)[8]) { u32x4 w; w.x = cvt_pk_bf16(x[0], x[1]); w.y = cvt_pk_bf16(x[2], x[3]); w.z = cvt_pk_bf16(x[4], x[5]); w.w = cvt_pk_bf16(x[6], x[7]); return w; }
__device__ __forceinline__ void head_norm_rope_store(const u32x4 (&w)[12], const float pre_nope, const float pre_rope, const float oscale, const float* g, const float* rc, const float* rs, bf16_t* dbase, const size_t doff) {
    float s = 0.f;
#pragma unroll
    for (int j = 0; j < 12; ++j) { float x[8]; unpack8h(w[j], x); const float p = j < 8 ? pre_nope : pre_rope;
#pragma unroll
        for (int i = 0; i < 8; ++i) { const float y = x[i] * p; s += y * y; } }
    const float r = 1.0f / sqrtf(s * (1.f / 96.f) + 1e-6f);
    const float rn = r * pre_nope * oscale, rr = r * pre_rope * oscale;
#pragma unroll
    for (int j = 0; j < 8; ++j) { float x[8]; unpack8h(w[j], x);
#pragma unroll
        for (int i = 0; i < 8; ++i) x[i] = (x[i] * rn) * g[8 * j + i];
        st16(dbase, doff + 8 * j, pack8h(x)); }
#pragma unroll
    for (int jj = 0; jj < 2; ++jj) { float x1[8], x2[8], o1[8], o2[8]; unpack8h(w[8 + jj], x1); unpack8h(w[10 + jj], x2);
        const f32x4 ca = *(const f32x4*)(rc + 8 * jj), cb = *(const f32x4*)(rc + 8 * jj + 4), sa = *(const f32x4*)(rs + 8 * jj), sb = *(const f32x4*)(rs + 8 * jj + 4);
        const float c[8] = {ca[0], ca[1], ca[2], ca[3], cb[0], cb[1], cb[2], cb[3]}, sn[8] = {sa[0], sa[1], sa[2], sa[3], sb[0], sb[1], sb[2], sb[3]};
#pragma unroll
        for (int i = 0; i < 8; ++i) { const float a = (x1[i] * rr) * g[64 + 8 * jj + i], b = (x2[i] * rr) * g[80 + 8 * jj + i]; o1[i] = a * c[i] - b * sn[i]; o2[i] = b * c[i] + a * sn[i]; }
        st16(dbase, doff + 64 + 8 * jj, pack8h(o1)); st16(dbase, doff + 80 + 8 * jj, pack8h(o2)); }
}
struct EpiQ {
    static constexpr bool PERM = true, AFTER_DRAIN = true;
    bf16_t* Q; const float* ssl; const float* g; const float* rc0; const float* rs0; int seqlen; float qscale;
    __device__ __forceinline__ void operator()(const f32x4 (&)[2][2][4][2], const Unit&, int, int, int, int) const {}
    __device__ __forceinline__ void fused(const f32x4 (&acc)[2][2][4][2], const Unit& u, int wr, int wc, int fr, int fq, PG8_LAS unsigned char* lds, int wid, int lane) const {
        stage_tile_f16(acc, lds, wr, wc, fr, fq);
        const int tid = wid * 64 + lane, row = tid & 255, hh = tid >> 8, t = u.pm * BM + row, head = 2 * u.pn + hh, b = t / seqlen, s = t - b * seqlen;
        u32x4 w[12];
#pragma unroll
        for (int j = 0; j < 12; ++j) w[j] = tile_chunk(lds, row, 16 * hh + j);
        const f32x4 sa = *(const f32x4*)(ssl + (size_t)t * 16), sb = *(const f32x4*)(ssl + (size_t)t * 16 + 4);
        const float rq = 1.0f / sqrtf((((sa[0] + sa[1]) + (sa[2] + sa[3])) + ((sb[0] + sb[1]) + (sb[2] + sb[3]))) * (1.f / 384.f) + 1e-6f);
        head_norm_rope_store(w, rq, rq, qscale, g, rc0 + s * 16, rs0 + s * 16, Q, ((size_t)(b * 8 + head) * seqlen + s) * 96);
        asm volatile("s_waitcnt lgkmcnt(0)" ::: "memory"); __builtin_amdgcn_s_barrier(); asm volatile("" ::: "memory");
    }
};
struct EpiKV {
    static constexpr bool PERM = true, AFTER_DRAIN = true;
    bf16_t* K; bf16_t* V; const bf16_t* LAT; int latw; const float* ssl; const float* g; const float* rc0; const float* rs0; int seqlen;
    __device__ __forceinline__ void operator()(const f32x4 (&)[2][2][4][2], const Unit&, int, int, int, int) const {}
    __device__ __forceinline__ void fused(const f32x4 (&acc)[2][2][4][2], const Unit& u, int wr, int wc, int fr, int fq, PG8_LAS unsigned char* lds, int wid, int lane) const {
        stage_tile_f16(acc, lds, wr, wc, fr, fq);
        const int tid = wid * 64 + lane, row = tid & 255, hh = tid >> 8, t = u.pm * BM + row, head = 2 * u.pn + hh, b = t / seqlen, s = t - b * seqlen;
        const size_t orow = (size_t)(b * 8 + head) * seqlen + s;
        const f32x4 sk = *(const f32x4*)(ssl + (size_t)t * 16 + 8);
        const float rkv = 1.0f / sqrtf(((sk[0] + sk[1]) + (sk[2] + sk[3])) * (1.f / 256.f) + 1e-6f);
        u32x4 w[12];
#pragma unroll
        for (int j = 0; j < 8; ++j) w[j] = tile_chunk(lds, row, 16 * hh + j);
#pragma unroll
        for (int j = 0; j < 4; ++j) w[8 + j] = *(const u32x4*)(LAT + (size_t)t * latw + 384 + 8 * j);
        head_norm_rope_store(w, rkv, 1.0f, 1.0f, g, rc0 + s * 16, rs0 + s * 16, K, orow * 96);
#pragma unroll
        for (int j = 0; j < 8; ++j) { float x[8]; unpack8h(tile_chunk(lds, row, 16 * hh + 8 + j), x);
#pragma unroll
            for (int i = 0; i < 8; ++i) x[i] *= rkv;
            st16(V, orow * 64 + 8 * j, pack8h(x)); }
        asm volatile("s_waitcnt lgkmcnt(0)" ::: "memory"); __builtin_amdgcn_s_barrier(); asm volatile("" ::: "memory");
    }
};
struct EpiBias {
    static constexpr bool PERM = true, AFTER_DRAIN = false;
    float* B;
    __device__ __forceinline__ void operator()(const f32x4 (&acc)[2][2][4][2], const Unit& u, int wr, int wc, int fr, int fq) const {
        if (wr != 0 || fr >= 10) return;
        const int l = u.pm >> 1, j = u.pn - l * 65;
        float* dst = B + ((size_t)l * 10 + fr) * (41 * 256) + j * BM + wc * 32 + 8 * fq;
#pragma unroll
        for (int bj = 0; bj < 2; ++bj)
#pragma unroll
            for (int n = 0; n < 2; ++n) *(f32x4*)(dst + bj * HALF + 4 * n) = acc[0][bj][0][n];
    }
};
struct BiasOrder {
    int G, c;
    __device__ __forceinline__ bool next(int i, Unit& u) const { const int L = i * G + c; if (L >= 4 * 41) return false; const int l = L / 41, j = L % 41; u.pm = 2 * l + (j >= 19 ? 1 : 0); u.pn = l * 65 + j; u.idx = i; return true; }
    __device__ __forceinline__ void a_ready(const Unit&) const {}
    __device__ __forceinline__ void done(const Unit&) const {}
};

template <int K, int LDA, int LDB, class Epi, class Sched, bool ALIGN_EPI = false, bool SP2 = false>
__device__ __forceinline__ void gemm_phase(PG8_LAS unsigned char* lds, const Gemm g, const Sched& S, const Epi& E, const int wave_sgpr) {
    int lane_; asm volatile("v_mbcnt_lo_u32_b32 %0, -1, 0\n\tv_mbcnt_hi_u32_b32 %0, -1, %0" : "=v"(lane_));
    const int wid = wave_sgpr, lane = lane_, tid = wid * 64 + lane, wr = wid >> 2, wc = wid & 3, fr = lane & 15, fq = lane >> 4;
    constexpr int nt = K / BK; static_assert(K % (2 * BK) == 0 && nt >= 2, "K must be a multiple of 128");
    unsigned voffA[2], voffB[2];
#pragma unroll
    for (int i = 0; i < 2; ++i) { int R, C; stage_rc(tid * 16 + i * 8192, R, C); const int Rb = Epi::PERM ? ((R & ~31) + perm32(R & 31)) : R;
        voffA[i] = (unsigned)(R * LDA + C) * 2u; voffB[i] = (unsigned)(Rb * LDB + C) * 2u; }
    const size_t kstep = (size_t)(BK * 2);
    const size_t hstepA = (size_t)HALF * LDA * 2, hstepB = (size_t)HALF * LDB * 2;
    const size_t tstepA = 2 * hstepA, tstepB = 2 * hstepB;
    const unsigned ldsw = (unsigned)wid * 1024u;
    const int aoff = lds_byte(wr * 64 + fr, fq * 8), boff = lds_byte(wc * 32 + fr, fq * 8);
#define PG8_SA(b, h) (((b) * 2 + (h)) * HTB)
#define PG8_SB(b, h) ((4 + (b) * 2 + (h)) * HTB)
#define PG8_STAGE(bufoff, gbase, voff) do { _Pragma("unroll") for (int _i = 0; _i < 2; ++_i) \
        __builtin_amdgcn_global_load_lds((const unsigned*)((const char*)(gbase) + (voff)[_i]), (PG8_LAS unsigned*)(lds + (bufoff) + ldsw + _i * 8192), 16, 0, 0); } while (0)
#define PG8_LDA(dst, b, h) do { _Pragma("unroll") for (int m = 0; m < 4; ++m) _Pragma("unroll") for (int k = 0; k < 2; ++k) dst[m][k] = *(const PG8_LAS bf16x8*)(lds + PG8_SA(b, h) + aoff + m * 2048 + k * 1024); } while (0)
#define PG8_LDB(dst, b, h) do { _Pragma("unroll") for (int n = 0; n < 2; ++n) _Pragma("unroll") for (int k = 0; k < 2; ++k) dst[n][k] = *(const PG8_LAS bf16x8*)(lds + PG8_SB(b, h) + boff + n * 2048 + k * 1024); } while (0)
#define PG8_MMA(ai, bj, At, Bt) do { __builtin_amdgcn_s_setprio(1); _Pragma("unroll") for (int m = 0; m < 4; ++m) _Pragma("unroll") for (int n = 0; n < 2; ++n) _Pragma("unroll") for (int k = 0; k < 2; ++k) \
        acc[ai][bj][m][n] = __builtin_amdgcn_mfma_f32_16x16x32_f16(Bt[n][k], At[m][k], acc[ai][bj][m][n], 0, 0, 0); __builtin_amdgcn_s_setprio(0); } while (0)
#define PG8_WAIT_V(n) asm volatile("s_waitcnt vmcnt(" #n ")" ::: "memory")
#define PG8_WAIT_L(n) asm volatile("s_waitcnt lgkmcnt(" #n ")" ::: "memory")
#define PG8_BAR __builtin_amdgcn_s_barrier()
#define PG8_SCHED __builtin_amdgcn_sched_barrier(0)
    Unit cur, nxt; int ui = 0;
    if (!S.next(0, cur)) return;
    f32x4 acc[2][2][4][2];
#pragma unroll
    for (int a = 0; a < 2; ++a)
#pragma unroll
        for (int b = 0; b < 2; ++b)
#pragma unroll
            for (int m = 0; m < 4; ++m)
#pragma unroll
                for (int n = 0; n < 2; ++n) acc[a][b][m][n] = (f32x4){0.f, 0.f, 0.f, 0.f};
    bf16x8 At[4][2], B0[2][2], B1[2][2];
    const char* cA = (const char*)g.A + (size_t)cur.pm * tstepA; const char* cB = (const char*)g.Bt + (size_t)cur.pn * tstepB;
    S.a_ready(cur);
    if constexpr (SP2) {
        PG8_STAGE(PG8_SB(0, 0), cB, voffB); PG8_STAGE(PG8_SB(0, 1), cB + hstepB, voffB); PG8_STAGE(PG8_SA(0, 0), cA, voffA); PG8_STAGE(PG8_SA(0, 1), cA + hstepA, voffA);
        if (wr == 1) PG8_BAR;
        PG8_WAIT_V(2); PG8_BAR;
        PG8_STAGE(PG8_SB(1, 0), cB + kstep, voffB); PG8_STAGE(PG8_SA(1, 0), cA + kstep, voffA); PG8_STAGE(PG8_SB(1, 1), cB + hstepB + kstep, voffB);
        PG8_WAIT_V(6); PG8_BAR;
    } else {
        PG8_STAGE(PG8_SB(0, 0), cB, voffB); PG8_STAGE(PG8_SA(0, 0), cA, voffA); PG8_STAGE(PG8_SB(0, 1), cB + hstepB, voffB); PG8_STAGE(PG8_SA(0, 1), cA + hstepA, voffA);
        if (wr == 1) PG8_BAR;
        PG8_WAIT_V(4); PG8_BAR;
        PG8_STAGE(PG8_SB(1, 0), cB + kstep, voffB); PG8_STAGE(PG8_SA(1, 0), cA + kstep, voffA); PG8_STAGE(PG8_SB(1, 1), cB + hstepB + kstep, voffB);
        PG8_WAIT_V(6); PG8_BAR;
    }
    for (;;) {
        const bool has_next = S.next(ui + 1, nxt);
        const char* nA = has_next ? (const char*)g.A + (size_t)nxt.pm * tstepA : cA; const char* nB = has_next ? (const char*)g.Bt + (size_t)nxt.pn * tstepB : cB;
#pragma nounroll
        for (int t = 0; t < nt; t += 2) {
            const bool last = (t == nt - 2);
            const char* a1 = cA + (size_t)(t + 1) * kstep;
            const char* a2 = last ? nA : cA + (size_t)(t + 2) * kstep; const char* b2 = last ? nB : cB + (size_t)(t + 2) * kstep;
            const char* a3 = a2 + kstep; const char* b3 = b2 + kstep;
            if (last && has_next) S.a_ready(nxt);
            if constexpr (SP2) {
            PG8_LDB(B0, 0, 0); PG8_LDB(B1, 0, 1); PG8_SCHED; PG8_LDA(At, 0, 0); PG8_STAGE(PG8_SA(1, 1), a1 + hstepA, voffA);
            PG8_WAIT_V(8); PG8_WAIT_L(0); PG8_BAR; PG8_MMA(0, 0, At, B0); PG8_MMA(0, 1, At, B1); PG8_BAR; PG8_SCHED;
            PG8_LDA(At, 0, 1); PG8_STAGE(PG8_SB(0, 0), b2, voffB); PG8_STAGE(PG8_SB(0, 1), b2 + hstepB, voffB); PG8_STAGE(PG8_SA(0, 0), a2, voffA);
            PG8_WAIT_V(8); PG8_WAIT_L(0); PG8_BAR; PG8_MMA(1, 0, At, B0); PG8_MMA(1, 1, At, B1); PG8_BAR; PG8_SCHED;
            PG8_LDB(B0, 1, 0); PG8_LDB(B1, 1, 1); PG8_SCHED; PG8_LDA(At, 1, 0); PG8_STAGE(PG8_SA(0, 1), a2 + hstepA, voffA);
            PG8_WAIT_V(8); PG8_WAIT_L(0); PG8_BAR; PG8_MMA(0, 0, At, B0); PG8_MMA(0, 1, At, B1); PG8_BAR; PG8_SCHED;
            PG8_LDA(At, 1, 1); PG8_STAGE(PG8_SB(1, 0), b3, voffB); PG8_STAGE(PG8_SB(1, 1), b3 + hstepB, voffB); PG8_STAGE(PG8_SA(1, 0), a3, voffA);
            PG8_WAIT_V(8); PG8_WAIT_L(0); PG8_BAR; PG8_MMA(1, 0, At, B0); PG8_MMA(1, 1, At, B1); PG8_BAR; PG8_SCHED;
            } else {
            PG8_LDB(B0, 0, 0); PG8_SCHED; PG8_LDA(At, 0, 0); PG8_STAGE(PG8_SA(1, 1), a1 + hstepA, voffA);
            PG8_WAIT_L(8); PG8_BAR; PG8_WAIT_L(0); PG8_MMA(0, 0, At, B0); PG8_BAR; PG8_SCHED;
            PG8_LDB(B1, 0, 1); PG8_STAGE(PG8_SB(0, 0), b2, voffB);
            PG8_BAR; PG8_WAIT_L(0); PG8_MMA(0, 1, At, B1); PG8_BAR;
            PG8_LDA(At, 0, 1); PG8_STAGE(PG8_SA(0, 0), a2, voffA);
            PG8_BAR; PG8_WAIT_L(0); PG8_MMA(1, 0, At, B0); PG8_BAR; PG8_SCHED;
            PG8_STAGE(PG8_SB(0, 1), b2 + hstepB, voffB);
            PG8_WAIT_V(6); PG8_BAR; PG8_MMA(1, 1, At, B1); PG8_BAR;
            PG8_LDB(B0, 1, 0); PG8_SCHED; PG8_LDA(At, 1, 0); PG8_STAGE(PG8_SA(0, 1), a2 + hstepA, voffA);
            PG8_WAIT_L(8); PG8_BAR; PG8_WAIT_L(0); PG8_MMA(0, 0, At, B0); PG8_BAR; PG8_SCHED;
            PG8_LDB(B1, 1, 1); PG8_STAGE(PG8_SB(1, 0), b3, voffB);
            PG8_BAR; PG8_WAIT_L(0); PG8_MMA(0, 1, At, B1); PG8_BAR;
            PG8_LDA(At, 1, 1); PG8_STAGE(PG8_SA(1, 0), a3, voffA);
            PG8_BAR; PG8_WAIT_L(0); PG8_MMA(1, 0, At, B0); PG8_BAR; PG8_SCHED;
            PG8_STAGE(PG8_SB(1, 1), b3 + hstepB, voffB);
            PG8_WAIT_V(6); PG8_BAR; PG8_MMA(1, 1, At, B1); PG8_BAR;
            }
        }
        if constexpr (ALIGN_EPI) { if (wr == 0) PG8_BAR; }
        if constexpr (!Epi::AFTER_DRAIN) { E(acc, cur, wr, wc, fr, fq); S.done(cur); }
        if (!has_next) break;
#pragma unroll
        for (int a = 0; a < 2; ++a)
#pragma unroll
            for (int b = 0; b < 2; ++b)
#pragma unroll
                for (int m = 0; m < 4; ++m)
#pragma unroll
                    for (int n = 0; n < 2; ++n) acc[a][b][m][n] = (f32x4){0.f, 0.f, 0.f, 0.f};
        cur = nxt; cA = nA; cB = nB; ++ui;
        if constexpr (ALIGN_EPI) { if (wr == 1) PG8_BAR; }
    }
    PG8_WAIT_V(0);
    if constexpr (!ALIGN_EPI) { if (wr == 0) PG8_BAR; }
    PG8_BAR;
    if constexpr (Epi::AFTER_DRAIN) { E.fused(acc, cur, wr, wc, fr, fq, lds, wid, lane); S.done(cur); }
#undef PG8_SA
#undef PG8_SB
#undef PG8_STAGE
#undef PG8_LDA
#undef PG8_LDB
#undef PG8_MMA
#undef PG8_WAIT_V
#undef PG8_WAIT_L
#undef PG8_BAR
#undef PG8_SCHED
}
}

namespace att2 {
typedef unsigned short bf16;
using bf16x8=__attribute__((ext_vector_type(8)))short;
using s16x4=__attribute__((ext_vector_type(4)))short;
using f32x16=__attribute__((ext_vector_type(16)))float;
using u32x4=__attribute__((ext_vector_type(4)))unsigned;
typedef _Float16 h16x8 __attribute__((ext_vector_type(8)));
constexpr int DQK=96,DV=64,OPITCH=512;
constexpr int NW=8,QBLK=32,QB=QBLK*NW,KVBLK=64;
__device__ __forceinline__ int crow(int r,int hi){return (r&3)+8*(r>>2)+4*hi;}
#define SBAR() __builtin_amdgcn_sched_barrier(0)
#define MFMA32(a,b,c) __builtin_amdgcn_mfma_f32_32x32x16_f16(__builtin_bit_cast(h16x8,a),__builtin_bit_cast(h16x8,b),c,0,0,0)
constexpr int NSLOT=3, KSLOT=12288, VSLOT=8192;
constexpr int LDS_K=0, LDS_V=NSLOT*KSLOT, LDS_WS=LDS_V+NSLOT*VSLOT, LDS_OST=LDS_WS+NW*64*4, LDS_BYTES=LDS_OST+NW*4096;
constexpr float QSCALE=0.10206207261596575f*1.4426950408889634f;
__device__ __forceinline__ void glds16(const void*gsrc,unsigned lds_dst){unsigned keep;
  asm volatile("s_mov_b32 %0, m0\n\ts_mov_b32 m0, %2\n\ts_nop 0\n\tglobal_load_lds_dwordx4 %1, off\n\ts_mov_b32 m0, %0":"=&s"(keep):"v"(gsrc),"s"(lds_dst):"memory");}
__device__ __forceinline__ float max3f(float a,float b,float c){float r;asm("v_max3_f32 %0, %1, %2, %3":"=v"(r):"v"(a),"v"(b),"v"(c));return r;}
__device__ __forceinline__ float max2f(float a,float b){float r;asm("v_max_f32_e32 %0, %1, %2":"=v"(r):"v"(a),"v"(b));return r;}
__device__ __forceinline__ float fadd_s(float a,float b){float r;asm("v_add_f32_e32 %0, %1, %2":"=v"(r):"v"(a),"v"(b));return r;}
__device__ __forceinline__ float fsub_s(float a,float b){float r;asm("v_sub_f32_e32 %0, %1, %2":"=v"(r):"v"(a),"v"(b));return r;}
typedef float f32x2_t __attribute__((ext_vector_type(2))); typedef _Float16 h16x2_t __attribute__((ext_vector_type(2)));
__device__ __forceinline__ unsigned cvtpk_s(float lo,float hi){f32x2_t v={lo,hi};h16x2_t b=__builtin_convertvector(v,h16x2_t);return __builtin_bit_cast(unsigned,b);}
#define WAIT_BAR(N) asm volatile("s_waitcnt vmcnt(" #N ") lgkmcnt(0)\n\ts_barrier":::"memory")

__device__ __forceinline__ void qkt(f32x16&p0,f32x16&p1,const char*Kslot,const bf16x8*qr,const f32x16&negm,int r32,int hi){
  const char*kb=Kslot+hi*1024+r32*16;
  #pragma unroll
  for(int d0=0;d0<6;++d0){
    const bf16x8 b0=*reinterpret_cast<const bf16x8*>(kb+d0*2048);
    const bf16x8 b1=*reinterpret_cast<const bf16x8*>(kb+d0*2048+512);
    if(d0==0){p0=MFMA32(b0,qr[0],negm);p1=MFMA32(b1,qr[0],negm);}
    else{p0=MFMA32(b0,qr[d0],p0);p1=MFMA32(b1,qr[d0],p1);}}
}
typedef __attribute__((address_space(3))) const char* lds_cptr;
typedef short v4i16_t __attribute__((ext_vector_type(4)));
__device__ __forceinline__ void kload2(bf16x8*kf,lds_cptr kp,int j){ kf[2*j]=*(const __attribute__((address_space(3))) bf16x8*)(kp+j*2048); kf[2*j+1]=*(const __attribute__((address_space(3))) bf16x8*)(kp+j*2048+512); }
__device__ __forceinline__ s16x4 vtr(lds_cptr p){ return __builtin_bit_cast(s16x4,__builtin_amdgcn_ds_read_tr16_b64_v4i16((__attribute__((address_space(3))) v4i16_t*)p)); }
__device__ __forceinline__ float rowmax(const f32x16&p0,const f32x16&p1){
  float a=max3f(p0[0],p0[1],p1[0]),b=max3f(p0[2],p0[3],p1[1]);a=max3f(a,p1[2],p1[3]);
  #pragma unroll
  for(int r=4;r<16;r+=4){a=max3f(a,p0[r],p0[r+1]);b=max3f(b,p0[r+2],p0[r+3]);a=max3f(a,p1[r],p1[r+1]);b=max3f(b,p1[r+2],p1[r+3]);}
  const float m=max2f(a,b);
  auto rr=__builtin_amdgcn_permlane32_swap(__float_as_uint(m),__float_as_uint(m),false,false);
  return max2f(__uint_as_float(rr[0]),__uint_as_float(rr[1]));
}
__device__ __forceinline__ void pv(f32x16*o,int vb,bf16x8 pa0,bf16x8 pa1,bf16x8 pa2,bf16x8 pa3){
  #pragma unroll
  for(int d0=0;d0<2;++d0){s16x4 lo[4],hi[4];
    #pragma unroll
    for(int ks=0;ks<4;++ks){
      asm volatile("ds_read_b64_tr_b16 %0,%1 offset:%c2":"=&v"(lo[ks]):"v"(vb),"i"(d0*4096+ks*1024):"memory");
      asm volatile("ds_read_b64_tr_b16 %0,%1 offset:%c2":"=&v"(hi[ks]):"v"(vb),"i"(d0*4096+ks*1024+512):"memory");}
    asm volatile("s_waitcnt lgkmcnt(0)":::"memory");SBAR();
    #define PK(k) (bf16x8){lo[k][0],lo[k][1],lo[k][2],lo[k][3],hi[k][0],hi[k][1],hi[k][2],hi[k][3]}
    o[d0]=MFMA32(pa0,PK(0),o[d0]);
    o[d0]=MFMA32(pa1,PK(1),o[d0]);
    o[d0]=MFMA32(pa2,PK(2),o[d0]);
    o[d0]=MFMA32(pa3,PK(3),o[d0]);
    #undef PK
  }
}

template<int THRL> __device__ __forceinline__ void attn_unit(const int wave_sgpr,const bf16*Qu,const bf16*__restrict__ Kh,const bf16*__restrict__ Vh,bf16*Ou,const int NT,char*shm){
  int lane_; asm volatile("v_mbcnt_lo_u32_b32 %0, -1, 0\n\tv_mbcnt_hi_u32_b32 %0, -1, %0" : "=v"(lane_));
  const int lane=lane_,r32=lane&31,hi=lane>>5; const int wid=wave_sgpr;
  const bf16*Qw=Qu+(long)(wid*QBLK)*DQK;
  const unsigned lds0=(unsigned)(uintptr_t)shm;
  float*wsf=(float*)(shm+LDS_WS)+wid*64;
  const int kcB=8+(wid&3);
  const bf16*ksrcA=Kh+(long)lane*DQK+wid*8;
  const bf16*ksrcB=Kh+(long)lane*DQK+kcB*8;
  const bf16*vsrc=Vh+(long)(16*(wid&3)+(lane>>2))*DV+(wid>>2)*32+(lane&3)*8;
  const unsigned kdstA=lds0+LDS_K+wid*1024, kdstB=lds0+LDS_K+kcB*1024, vdst=lds0+LDS_V+wid*1024;
  #define DMA_K(t,si) do{ glds16(ksrcA+(long)(t)*KVBLK*DQK,(unsigned)__builtin_amdgcn_readfirstlane(kdstA+(si)*KSLOT)); glds16(ksrcB+(long)(t)*KVBLK*DQK,(unsigned)__builtin_amdgcn_readfirstlane(kdstB+(si)*KSLOT)); }while(0)
  #define DMA_V(t,si) glds16(vsrc+(long)(t)*KVBLK*DV,(unsigned)__builtin_amdgcn_readfirstlane(vdst+(si)*VSLOT))
  const int vb0=(int)(lds0+LDS_V)+((lane>>4)&1)*32+(lane&3)*8+(4*hi+((lane&15)>>2))*64;
  const char*Kbase=shm+LDS_K; bf16x8 kf[12];
  const lds_cptr shm3=(lds_cptr)shm; const lds_cptr kp0=shm3+LDS_K+hi*1024+r32*16; const lds_cptr vp0=shm3+LDS_V+((lane>>4)&1)*32+(lane&3)*8+(4*hi+((lane&15)>>2))*64;
  DMA_K(0,0);DMA_V(0,0);DMA_K(1,1);
  bf16x8 qr[6];
  #pragma unroll
  for(int d0=0;d0<6;++d0)qr[d0]=*reinterpret_cast<const bf16x8*>(&Qw[(long)r32*DQK+d0*16+hi*8]);
  float mhat=0.f,l_reg=0.f;f32x16 o[2];o[0]=f32x16{};o[1]=f32x16{};f32x16 negm=f32x16{};asm volatile("":"+v"(negm));
  bool resc=false;
  #define START(P0,P1) do{ const float rm=rowmax(P0,P1); resc=false; \
    { const float dl=rm; mhat=fadd_s(mhat,dl); \
      _Pragma("unroll") for(int r=0;r<16;++r){P0[r]=fsub_s(P0[r],dl);P1[r]=fsub_s(P1[r],dl);} \
      _Pragma("unroll") for(int r=0;r<16;++r)negm[r]=-mhat; asm volatile("":"+v"(negm)); } \
    _Pragma("unroll") for(int r=0;r<16;++r)P0[r]=__builtin_amdgcn_exp2f(P0[r]); }while(0)
  #define RESC() do{ if(resc){ asm volatile("s_waitcnt lgkmcnt(0)":::"memory"); \
      _Pragma("unroll") for(int d_=0;d_<2;++d_) _Pragma("unroll") for(int r=0;r<16;++r)o[d_][r]*=wsf[crow(r,hi)]; } }while(0)
  f32x16 pA0,pA1,pB0,pB1;
  int sl_prev=0,sl_cur=0,sl_next=1;
  #define ROT() do{sl_prev=sl_cur;sl_cur=sl_next;sl_next=(sl_next==NSLOT-1)?0:sl_next+1;}while(0)
  DMA_K(2,2);
  WAIT_BAR(5);
  qkt(pA0,pA1,Kbase,qr,negm,r32,hi);asm volatile("s_nop 15\n\ts_nop 7":"+v"(pA0),"+v"(pA1));
  START(pA0,pA1);
  _Pragma("unroll") for(int r=0;r<16;++r)pA1[r]=__builtin_amdgcn_exp2f(pA1[r]);
  WAIT_BAR(0);
  DMA_K(3,0);DMA_V(1,1);
  ROT();
  #pragma unroll
  for(int j=0;j<6;++j)kload2(kf,kp0+sl_cur*KSLOT,j);
  WAIT_BAR(3);
  s16x4 vlo[8],vhi[8]; u32x4 pw0,pw1,pw2,pw3;
  #define PKW(P,B) cvtpk_s(P[B],P[B+1])
  #define PAF(k) __builtin_bit_cast(bf16x8,pw##k)
  #define VFR(i) (bf16x8){vlo[i][0],vlo[i][1],vlo[i][2],vlo[i][3],vhi[i][0],vhi[i][1],vhi[i][2],vhi[i][3]}
  #define PIN(x) asm volatile("":"+v"(x))
  #define MX3(a,b,c) __builtin_fmaxf(__builtin_fmaxf((a),(b)),(c))
  #define EX(v) __builtin_amdgcn_exp2f(v)
  #define GAPB(MF,X,B) do{ MF; X[B]=EX(X[B]); X[B+1]=EX(X[B+1]); X[B+2]=EX(X[B+2]); X[B+3]=EX(X[B+3]); PIN(X); SBAR(); }while(0)
  #define VRD(i) do{ vlo[i]=vtr(vp_+(((i)>>2)*4096+((i)&3)*1024)); vhi[i]=vtr(vp_+(((i)>>2)*4096+((i)&3)*1024+512)); }while(0)
  #define KRD(G,j) do{ if(G){ kload2(kf,kp0+sl_next*KSLOT,j); SBAR(); } }while(0)
  #define STEP(C0,C1,P0,P1,t,GK,GV,GL) do{ SBAR(); \
    const lds_cptr vp_=vp0+sl_prev*VSLOT; \
    VRD(0); SBAR(); float sacc=(P0[0]+P0[1]); \
    C0=MFMA32(kf[0],qr[0],negm); sacc+=P0[2]; sacc+=P0[3]; sacc+=P0[4]; PIN(sacc); pw0[0]=PKW(P0,0); pw0[1]=PKW(P0,2); PIN(pw0); SBAR(); \
    VRD(4); SBAR(); C1=MFMA32(kf[1],qr[0],negm); sacc+=P0[5]; sacc+=P0[6]; sacc+=P0[7]; PIN(sacc); pw0[2]=PKW(P0,4); PIN(pw0); SBAR(); \
    VRD(1); SBAR(); C0=MFMA32(kf[2],qr[1],C0); sacc+=P0[8]; sacc+=P0[9]; sacc+=P0[10]; PIN(sacc); pw0[3]=PKW(P0,6); pw1[0]=PKW(P0,8); PIN(pw0); PIN(pw1); SBAR(); \
    VRD(5); SBAR(); C1=MFMA32(kf[3],qr[1],C1); sacc+=P0[11]; sacc+=P0[12]; sacc+=P0[13]; PIN(sacc); pw1[1]=PKW(P0,10); PIN(pw1); SBAR(); \
    VRD(2); SBAR(); C0=MFMA32(kf[4],qr[2],C0); sacc+=P0[14]; sacc+=P0[15]; sacc+=P1[0]; PIN(sacc); pw1[2]=PKW(P0,12); pw1[3]=PKW(P0,14); PIN(pw1); SBAR(); \
    VRD(6); SBAR(); C1=MFMA32(kf[5],qr[2],C1); sacc+=P1[1]; sacc+=P1[2]; sacc+=P1[3]; PIN(sacc); pw2[0]=PKW(P1,0); PIN(pw2); SBAR(); \
    VRD(3); SBAR(); C0=MFMA32(kf[6],qr[3],C0); sacc+=P1[4]; sacc+=P1[5]; sacc+=P1[6]; PIN(sacc); pw2[1]=PKW(P1,2); pw2[2]=PKW(P1,4); PIN(pw2); SBAR(); \
    VRD(7); SBAR(); C1=MFMA32(kf[7],qr[3],C1); sacc+=P1[7]; sacc+=P1[8]; sacc+=P1[9]; PIN(sacc); pw2[3]=PKW(P1,6); PIN(pw2); SBAR(); \
    C0=MFMA32(kf[8],qr[4],C0); sacc+=P1[10]; sacc+=P1[11]; PIN(sacc); pw3[0]=PKW(P1,8); PIN(pw3); SBAR(); \
    C1=MFMA32(kf[9],qr[4],C1); sacc+=P1[12]; sacc+=P1[13]; PIN(sacc); pw3[1]=PKW(P1,10); PIN(pw3); SBAR(); \
    C0=MFMA32(kf[10],qr[5],C0); sacc+=P1[14]; PIN(sacc); pw3[2]=PKW(P1,12); PIN(pw3); SBAR(); \
    C1=MFMA32(kf[11],qr[5],C1); sacc+=P1[15]; PIN(sacc); pw3[3]=PKW(P1,14); PIN(pw3); SBAR(); \
    l_reg+=sacc; \
    if(GK){DMA_K((t)+3,sl_cur);} if(GV){DMA_V((t)+1,sl_next);} \
    { float a=MX3(C0[0],C0[1],C1[0]),b=MX3(C0[2],C0[3],C1[1]); a=MX3(a,C1[2],C1[3]); \
      _Pragma("unroll") for(int r=4;r<16;r+=4){a=MX3(a,C0[r],C0[r+1]);b=MX3(b,C0[r+2],C0[r+3]);a=MX3(a,C1[r],C1[r+1]);b=MX3(b,C1[r+2],C1[r+3]);} \
      float rm=__builtin_fmaxf(a,b); { auto rr=__builtin_amdgcn_permlane32_swap(__float_as_uint(rm),__float_as_uint(rm),false,false); rm=__builtin_fmaxf(__uint_as_float(rr[0]),__uint_as_float(rr[1])); } \
      resc=false; \
      if(__builtin_expect(__any(rm>(float)THRL),0)){ const float dl=__builtin_fmaxf(rm,0.f); mhat+=dl; \
        _Pragma("unroll") for(int r=0;r<16;++r){C0[r]-=dl;C1[r]-=dl;} \
        _Pragma("unroll") for(int r=0;r<16;++r)negm[r]=-mhat; asm volatile("":"+v"(negm)); \
        const float f=__builtin_amdgcn_exp2f(-dl); l_reg*=f; if(hi==0)wsf[r32]=f; resc=true; } } \
    SBAR(); \
    GAPB(o[0]=MFMA32(PAF(0),VFR(0),o[0]), C0,0); \
    KRD(GL,0); GAPB(o[1]=MFMA32(PAF(0),VFR(4),o[1]), C0,4); \
    KRD(GL,1); GAPB(o[0]=MFMA32(PAF(1),VFR(1),o[0]), C0,8); \
    KRD(GL,2); GAPB(o[1]=MFMA32(PAF(1),VFR(5),o[1]), C0,12); \
    KRD(GL,3); GAPB(o[0]=MFMA32(PAF(2),VFR(2),o[0]), C1,0); \
    KRD(GL,4); GAPB(o[1]=MFMA32(PAF(2),VFR(6),o[1]), C1,4); \
    KRD(GL,5); GAPB(o[0]=MFMA32(PAF(3),VFR(3),o[0]), C1,8); \
    GAPB(o[1]=MFMA32(PAF(3),VFR(7),o[1]), C1,12); \
    }while(0)
  int t=1;
  for(;t+5<NT;t+=2){
    STEP(pB0,pB1,pA0,pA1,t,true,true,true);     WAIT_BAR(3); RESC(); ROT();
    STEP(pA0,pA1,pB0,pB1,t+1,true,true,true);   WAIT_BAR(3); RESC(); ROT();
  }
  #define ENDW(tt) do{ if((tt)+3<NT){WAIT_BAR(3);} else if((tt)+2<NT){WAIT_BAR(1);} else {WAIT_BAR(0);} }while(0)
  for(;t+1<NT;t+=2){
    STEP(pB0,pB1,pA0,pA1,t,(t+3<NT),(t+1<NT),(t+1<NT));       ENDW(t);   RESC(); ROT();
    STEP(pA0,pA1,pB0,pB1,t+1,(t+4<NT),(t+2<NT),(t+2<NT));     ENDW(t+1); RESC(); ROT();
  }
  STEP(pB0,pB1,pA0,pA1,NT-1,false,false,false); RESC();
  { float sacc=pB0[0]+pB0[1]; _Pragma("unroll") for(int r=2;r<16;++r)sacc+=pB0[r]; _Pragma("unroll") for(int r=0;r<16;++r)sacc+=pB1[r]; l_reg+=sacc;
    pw0=(u32x4){PKW(pB0,0),PKW(pB0,2),PKW(pB0,4),PKW(pB0,6)};pw1=(u32x4){PKW(pB0,8),PKW(pB0,10),PKW(pB0,12),PKW(pB0,14)};pw2=(u32x4){PKW(pB1,0),PKW(pB1,2),PKW(pB1,4),PKW(pB1,6)};pw3=(u32x4){PKW(pB1,8),PKW(pB1,10),PKW(pB1,12),PKW(pB1,14)};
    SBAR(); pv(o,vb0+sl_cur*VSLOT,PAF(0),PAF(1),PAF(2),PAF(3)); }
  #undef PKW
  #undef PAF
  #undef VFR
  #undef PIN
  #undef MX3
  #undef GAPB
  #undef EX
  #undef VRD
  #undef KRD
  #undef STEP
  #undef ENDW
  {auto rr=__builtin_amdgcn_permlane32_swap(__float_as_uint(l_reg),__float_as_uint(l_reg),false,false);l_reg=__uint_as_float(rr[0])+__uint_as_float(rr[1]);}
  if(hi==0)wsf[32+r32]=l_reg;asm volatile("s_waitcnt lgkmcnt(0)":::"memory");
  float rli[16];
  #pragma unroll
  for(int r=0;r<16;++r)rli[r]=__builtin_amdgcn_rcpf(wsf[32+crow(r,hi)]);
  bf16*Ow=Ou+(long)(wid*QBLK)*OPITCH;
  { bf16*stg=(bf16*)(shm+LDS_OST)+wid*2048;
    #pragma unroll
    for(int r=0;r<16;++r){const int orow=crow(r,hi);
      #pragma unroll
      for(int d0=0;d0<2;++d0)stg[orow*64+d0*32+r32]=(bf16)(cvtpk_s(o[d0][r]*rli[r],0.f)&0xffffu);}
    asm volatile("s_waitcnt lgkmcnt(0)":::"memory");
    #pragma unroll
    for(int i=0;i<4;++i){const int row=i*8+(lane>>3),ch=lane&7; const u32x4 v=*(const u32x4*)(stg+row*64+ch*8); *(u32x4*)(Ow+(long)row*OPITCH+ch*8)=v;} }
  asm volatile("s_waitcnt lgkmcnt(0)\n\ts_barrier":::"memory");
  #undef DMA_K
  #undef DMA_V
  #undef START
  #undef RESC
  #undef ROT
}
#undef SBAR
#undef WAIT_BAR
#undef MFMA32
}


constexpr int NWAVES = 8;
constexpr int DM = 1024, NL = 4, TG = 16384  , NGRP = 2, NB = 10  ;
constexpr int NH = 8, DQK = 96, DV = 64, QLORA = 384, KVLORA = 256, DROPE = 32, NIN = 4768, NINP = 4864, DFF = 2816, NMOD = 6 * DM;
constexpr int LATW = 768;
constexpr float EPS = 1e-6f;
constexpr int KSPLIT = 8;
#ifndef MK_ONE_LAUNCH
#define MK_ONE_LAUNCH 1
#endif

constexpr size_t MiB = 1u << 20;
constexpr int TG2 = NGRP * TG;
constexpr size_t WS_CTL = 0, CTL_ZERO_BYTES = 1 * MiB;
constexpr size_t WS_MOD = 1 * MiB;
constexpr size_t WS_ROPE = 2 * MiB;
constexpr size_t WS_AV = 3 * MiB;
constexpr size_t WS_MODP = 4 * MiB;
constexpr size_t WS_SSL = 4 * MiB, WS_SSG = 5 * MiB;
constexpr size_t WS_SHA = 12 * MiB;
constexpr size_t WS_BIAS = 16 * MiB;
constexpr size_t WS_SSX = 18 * MiB;
constexpr size_t WS_WB = 20 * MiB, WB_LAYER = 65 * 512 * 1024;
constexpr size_t WO_IN = 0, WO_FI = WO_IN + (size_t)NINP * DM, WO_QB = WO_FI + (size_t)2 * DFF * DM, WO_KVB = WO_QB + (size_t)1024 * QLORA, WO_OA = WO_KVB + (size_t)1024 * KVLORA, WO_S = WO_OA + (size_t)DM * 512,
                 WO_OB = WO_S + (size_t)8 * 128 * 128, WO_OUT = WO_OB + (size_t)DM * DM, WO_FO = WO_OUT + (size_t)DM * DM, WO_END = WO_FO + (size_t)DM * DFF;
static_assert(WO_END * 2 <= WB_LAYER && WO_FI == (size_t)19 * 256 * 1024, "layer weight block");
constexpr size_t WS_HH = 150 * MiB;
constexpr size_t WS_X16 = 214 * MiB;
constexpr size_t WS_U = 278 * MiB, WS_GV = 310 * MiB, WS_SGA = 342 * MiB, WS_SGB = 374 * MiB;
constexpr size_t WS_TMP = 406 * MiB;
constexpr size_t WS_ACT = WS_U, WS_END = 454 * MiB;
static_assert(WS_ACT + (size_t)TG2 * DFF * 2 <= WS_END && WS_WB + NL * WB_LAYER <= WS_HH, "d_ws map");
constexpr size_t DO_Q = 0, DO_K = 24 * MiB, DO_V = 48 * MiB, DO_O = 64 * MiB, DO_LAT = 80 * MiB;
static_assert(DO_LAT + (size_t)TG * LATW * 2 <= (size_t)TG2 * DM * 4, "d_out scratch map");
constexpr int CW_BAR = 4096;

constexpr int RING_BYTES = 131072;
constexpr int LDSCTL_OFF = RING_BYTES, MISC_OFF = LDSCTL_OFF + 320;
constexpr int LDS_BYTES = 147456;
constexpr int RTAB_OFF = 132096;

#define GAS __attribute__((address_space(1)))
#define LAS __attribute__((address_space(3)))
typedef unsigned short bf16;
typedef unsigned v4u __attribute__((ext_vector_type(4)));
typedef unsigned v2u __attribute__((ext_vector_type(2)));
typedef float f32x4 __attribute__((ext_vector_type(4)));
typedef short bf16x8 __attribute__((ext_vector_type(8)));
#define LDS_WAIT() asm volatile("s_waitcnt lgkmcnt(0)" ::: "memory")
typedef _Float16 h16x2 __attribute__((ext_vector_type(2)));
typedef _Float16 h16x8 __attribute__((ext_vector_type(8)));
typedef float f32x2 __attribute__((ext_vector_type(2)));
__device__ __forceinline__ unsigned f2bf(float f) { return (unsigned)__builtin_bit_cast(unsigned short, (_Float16)f); }
__device__ __forceinline__ unsigned pk2(float lo, float hi) { const f32x2 v = {lo, hi}; return __builtin_bit_cast(unsigned, __builtin_convertvector(v, h16x2)); }
__device__ __forceinline__ float bflo(unsigned w) { return (float)__builtin_bit_cast(h16x2, w)[0]; }
__device__ __forceinline__ float bfhi(unsigned w) { return (float)__builtin_bit_cast(h16x2, w)[1]; }
__device__ __forceinline__ float wave_sum(float v) {
    v += __int_as_float(__builtin_amdgcn_ds_swizzle(__float_as_int(v), 0x041F));
    v += __int_as_float(__builtin_amdgcn_ds_swizzle(__float_as_int(v), 0x081F));
    v += __int_as_float(__builtin_amdgcn_ds_swizzle(__float_as_int(v), 0x101F));
    v += __int_as_float(__builtin_amdgcn_ds_swizzle(__float_as_int(v), 0x201F));
    v += __int_as_float(__builtin_amdgcn_ds_swizzle(__float_as_int(v), 0x401F));
    auto rr = __builtin_amdgcn_permlane32_swap(__float_as_uint(v), __float_as_uint(v), false, false);
    return __uint_as_float(rr[0]) + __uint_as_float(rr[1]);
}

__device__ __forceinline__ int lane_id_now() { int l; asm volatile("v_mbcnt_lo_u32_b32 %0, -1, 0\n\tv_mbcnt_hi_u32_b32 %0, -1, %0" : "=v"(l)); return l; }

#define XB_TMO      128
#define XB_XCNT(j)  (256  + 64 * (j))
#define XB_XSUB(j)  (1280 + 64 * (j))
#define XB_XGEN(j)  (2304 + 64 * (j))
#define XB_TOP      3328
#define XB_TOPGEN   3392
#define XCD_BAR_WORDS 3456
#define XB_SPIN_CAP (1u << 18)

__device__ __forceinline__ unsigned xb_ld(unsigned* p)              { return __hip_atomic_load(p, __ATOMIC_RELAXED, __HIP_MEMORY_SCOPE_AGENT); }
__device__ __forceinline__ unsigned xb_add(unsigned* p, unsigned v) { return __hip_atomic_fetch_add(p, v, __ATOMIC_RELAXED, __HIP_MEMORY_SCOPE_AGENT); }
__device__ __forceinline__ unsigned xb_xcc_id() { return (unsigned)__builtin_amdgcn_s_getreg((3 << 11) | 20) & 0xFu; }
#define XB_SPIN(cond, bar) do { unsigned _sp = 0; while (cond) { __builtin_amdgcn_s_sleep(1); \
    if ((++_sp & 255u) == 0u) { if (xb_ld(&(bar)[XB_TMO])) break; if (_sp > XB_SPIN_CAP) { atomicAdd(&(bar)[XB_TMO], 1u); break; } } } } while (0)

struct XcdBarrier {
    unsigned* bar; unsigned x;
    volatile LAS unsigned* st;
};

__device__ __forceinline__ XcdBarrier xcd_barrier_post(unsigned* bar, volatile LAS unsigned* st) {
    XcdBarrier b; b.bar = bar; b.x = xb_xcc_id(); b.st = st;
    if (threadIdx.x == 0) (void)xb_add(&bar[XB_XCNT(b.x)], 1u);
    return b;
}
__device__ __forceinline__ void xcd_barrier_complete(unsigned* bar, unsigned x, unsigned& nloc, unsigned& nx) {
    const unsigned G = gridDim.x * gridDim.y * gridDim.z;
    unsigned sum, cnt, mine, sp = 0u;
    for (;;) {
        sum = 0u; cnt = 0u; mine = 0u;
#pragma unroll
        for (unsigned j = 0; j < 16; ++j) { const unsigned c = xb_ld(&bar[XB_XCNT(j)]); sum += c; cnt += (c > 0u) ? 1u : 0u; mine = (j == x) ? c : mine; }
        if (sum == G) break;
        __builtin_amdgcn_s_sleep(1);
        if ((++sp & 255u) == 0u) { if (xb_ld(&bar[XB_TMO])) break; if (sp > XB_SPIN_CAP) { atomicAdd(&bar[XB_TMO], 1u); break; } }
    }
    nloc = mine > 0u ? mine : 1u; nx = cnt > 0u ? cnt : 1u;
}

__device__ __forceinline__ void xcd_barrier(const XcdBarrier& b) {
    asm volatile("s_waitcnt vmcnt(0)" ::: "memory");
    __syncthreads();
    if (threadIdx.x == 0) {
        unsigned* bar = b.bar;
        __builtin_amdgcn_s_waitcnt(0);
        unsigned nloc = b.st[0], nx = b.st[1];
        if (nloc == 0u) { xcd_barrier_complete(bar, b.x, nloc, nx); b.st[0] = nloc; b.st[1] = nx; }
        const unsigned old = xb_add(&bar[XB_XSUB(b.x)], 1u);
        const unsigned gen = old / nloc;
        if (old + 1u == (gen + 1u) * nloc) {
            __builtin_amdgcn_fence(__ATOMIC_RELEASE, "agent");
            asm volatile("s_waitcnt vmcnt(0)" ::: "memory");
            const unsigned og = xb_add(&bar[XB_TOP], 1u);
            const unsigned tg = og / nx;
            if (og + 1u == (tg + 1u) * nx) xb_add(&bar[XB_TOPGEN], 1u);
            else XB_SPIN(xb_ld(&bar[XB_TOPGEN]) == tg, bar);
            __builtin_amdgcn_fence(__ATOMIC_ACQUIRE, "agent");
            xb_add(&bar[XB_XGEN(b.x)], 1u);
            asm volatile("s_waitcnt vmcnt(0)" ::: "memory");
        } else {
            XB_SPIN(xb_ld(&bar[XB_XGEN(b.x)]) == gen, bar);
            __builtin_amdgcn_fence(__ATOMIC_ACQUIRE, "agent");
            asm volatile("s_waitcnt vmcnt(0)" ::: "memory");
        }
    }
    __syncthreads();
}

struct Frame {
    LAS unsigned char* lds;
    int tid, lane, wave, vcu, G;
    const float* in[23]; float* out; unsigned char* ws;
};
__constant__ double ROPE_INV[16] = {1.0, 0.5623413251903491, 0.31622776601683794, 0.1778279410038923, 0.1, 0.05623413251903491, 0.03162277660168379, 0.01778279410038923,
                                    0.01, 0.005623413251903491, 0.0031622776601683794, 0.0017782794100389228, 0.001, 0.0005623413251903491, 0.00031622776601683794, 0.00017782794100389227};

__device__ __forceinline__ void transpose_item(const float* W, int K, int N, bf16* WT, int k0, int n0, int drow0, const float* kscale, LAS float* scr, int lane) {
#pragma unroll 8
    for (int i = 0; i < 32; ++i) { const int kk = 2 * i + (lane >> 5); float v = W[(size_t)(k0 + kk) * N + n0 + (lane & 31)]; if (kscale) v *= kscale[k0 + kk]; scr[kk * 33 + (lane & 31)] = v; }
    LDS_WAIT(); asm volatile("" ::: "memory");
    const int c = lane & 7;
#pragma unroll
    for (int j = 0; j < 4; ++j) { const int n = (lane >> 3) + 8 * j; const LAS float* s = scr + (8 * c) * 33 + n;
        v4u o; o.x = pk2(s[0 * 33], s[1 * 33]); o.y = pk2(s[2 * 33], s[3 * 33]); o.z = pk2(s[4 * 33], s[5 * 33]); o.w = pk2(s[6 * 33], s[7 * 33]);
        *(GAS v4u*)(WT + (size_t)(drow0 + n) * K + k0 + 8 * c) = o; }
    LDS_WAIT(); asm volatile("" ::: "memory");
}
__device__ __forceinline__ int win_row(int n0) { return n0 < 384 ? n0 : (n0 < 640 ? 512 + (n0 - 384) : (n0 < 672 ? 384 + (n0 - 640) : 768 + (n0 - 672))); }
__device__ __forceinline__ int wfi_row(int n0) { const int g = n0 >= DFF ? 1 : 0, n = n0 - g * DFF; return (n >> 7) * 256 + g * 128 + (n & 127); }

__device__ __forceinline__ void pre0(Frame& F) {
    LAS float* scr = (LAS float*)(F.lds + F.wave * 16384);
    const int gw = F.vcu * NWAVES + F.wave, NGW = F.G * NWAVES;
    constexpr int I_IN = (DM / 64) * (NIN / 32), I_QB = (QLORA / 64) * (768 / 32), I_KVB = (KVLORA / 64) * (1024 / 32), I_OA = (512 / 64) * (DM / 32), I_OB = (DM / 64) * (DM / 32), I_OUT = I_OB,
                  I_FI = (DM / 64) * (2 * DFF / 32), I_FO = (DFF / 64) * (DM / 32), I_L = I_IN + I_QB + I_KVB + I_OA + I_OB + I_OUT + I_FI + I_FO;
    for (int it = gw; it < NL * I_L; it += NGW) {
        const int l = it / I_L; int r = it % I_L;
        bf16* wb = (bf16*)(F.ws + WS_WB + (size_t)l * WB_LAYER);
        if (r < I_IN) { const int nb = NIN / 32, kb = r / nb, n0 = (r % nb) * 32; transpose_item(F.in[7] + (size_t)l * DM * NIN, DM, NIN, wb + WO_IN, kb * 64, n0, win_row(n0), nullptr, scr, F.lane); continue; } r -= I_IN;
        if (r < I_QB) { const int nb = 768 / 32, kb = r / nb, n0 = (r % nb) * 32; transpose_item(F.in[10] + (size_t)l * QLORA * 768, QLORA, 768, wb + WO_QB, kb * 64, n0, (n0 / 96) * 128 + n0 % 96, F.in[8] + l * QLORA, scr, F.lane); continue; } r -= I_QB;
        if (r < I_KVB) { const int nb = 1024 / 32, kb = r / nb, n0 = (r % nb) * 32; transpose_item(F.in[11] + (size_t)l * KVLORA * 1024, KVLORA, 1024, wb + WO_KVB, kb * 64, n0, n0, F.in[9] + l * KVLORA, scr, F.lane); continue; } r -= I_KVB;
        if (r < I_OA) { const int nb = DM / 32, kb = r / nb, n0 = (r % nb) * 32; transpose_item(F.in[14] + (size_t)l * 512 * DM, 512, DM, wb + WO_OA, kb * 64, n0, n0, nullptr, scr, F.lane); continue; } r -= I_OA;
        if (r < I_OB) { const int nb = DM / 32, kb = r / nb, n0 = (r % nb) * 32; transpose_item(F.in[18] + (size_t)l * DM * DM, DM, DM, wb + WO_OB, kb * 64, n0, n0, nullptr, scr, F.lane); continue; } r -= I_OB;
        if (r < I_OUT) { const int nb = DM / 32, kb = r / nb, n0 = (r % nb) * 32; transpose_item(F.in[19] + (size_t)l * DM * DM, DM, DM, wb + WO_OUT, kb * 64, n0, n0, nullptr, scr, F.lane); continue; } r -= I_OUT;
        if (r < I_FI) { const int nb = 2 * DFF / 32, kb = r / nb, n0 = (r % nb) * 32; transpose_item(F.in[21] + (size_t)l * DM * 2 * DFF, DM, 2 * DFF, wb + WO_FI, kb * 64, n0, wfi_row(n0), nullptr, scr, F.lane); continue; } r -= I_FI;
        { const int nb = DM / 32, kb = r / nb, n0 = (r % nb) * 32; transpose_item(F.in[22] + (size_t)l * DFF * DM, DFF, DM, wb + WO_FO, kb * 64, n0, n0, nullptr, scr, F.lane); }
    }
    {
        const int gt = F.vcu * (NWAVES * 64) + F.tid, NT = F.G * NWAVES * 64;
        for (int i = gt; i < NL * 96 * (DM / 8); i += NT) { const int l = i / (96 * (DM / 8)), r = i % (96 * (DM / 8));
            *(GAS v4u*)((bf16*)(F.ws + WS_WB + (size_t)l * WB_LAYER) + WO_IN + (size_t)(416 + r / (DM / 8)) * DM + (r % (DM / 8)) * 8) = (v4u){0u, 0u, 0u, 0u}; }
        for (int i = gt; i < NL * 8 * 32 * (QLORA / 8); i += NT) { const int l = i / (8 * 32 * (QLORA / 8)), r = i % (8 * 32 * (QLORA / 8)), rw = r / (QLORA / 8);
            *(GAS v4u*)((bf16*)(F.ws + WS_WB + (size_t)l * WB_LAYER) + WO_QB + (size_t)((rw >> 5) * 128 + 96 + (rw & 31)) * QLORA + (r % (QLORA / 8)) * 8) = (v4u){0u, 0u, 0u, 0u}; }
        for (int i = gt; i < NL * 8 * 128 * 128 / 4; i += NT) { const int l = i / (8 * 128 * 128 / 4), r = i % (8 * 128 * 128 / 4);
            const f32x4 v = *(const f32x4*)(F.in[16] + (size_t)l * 131072 + (size_t)r * 4);
            *(GAS v2u*)((bf16*)(F.ws + WS_WB + (size_t)l * WB_LAYER) + WO_S + (size_t)r * 4) = (v2u){pk2(v.x, v.y), pk2(v.z, v.w)}; }
        float* rc = (float*)(F.ws + WS_ROPE); float* rs = rc + 8192 * 16;
        for (int i = gt; i < 8192 * 16; i += NT) { const int pos = i >> 4, k = i & 15;
            double t = (double)pos * ROPE_INV[k] * 0.15915494309189535; t -= __builtin_rint(t);
            const float tf = (float)t; rc[i] = __builtin_amdgcn_cosf(tf); rs[i] = __builtin_amdgcn_sinf(tf); }
    }
    {
        LAS float* sv = (LAS float*)F.lds;
        constexpr int NCB = NMOD / 512, NITEM = NL * KSPLIT * NCB;
        for (int it = F.vcu; it < NITEM; it += F.G) {
            const int l = it / (KSPLIT * NCB), kc = (it / NCB) % KSPLIT, cb = it % NCB;
            __syncthreads();
            for (int i = F.tid; i < NB * 128; i += NWAVES * 64) { const int b = i >> 7, k = kc * 128 + (i & 127);
                const float c = b < 2 ? F.in[2][b * DM + k] : F.in[3][(b - 2) * DM + k]; sv[i] = c * __builtin_amdgcn_rcpf(1.0f + __expf(-c)); }
            __syncthreads();
            const int n = cb * 512 + F.tid; const float* w = F.in[4] + ((size_t)l * DM + kc * 128) * NMOD + n;
            float a[NB];
#pragma unroll
            for (int b = 0; b < NB; ++b) a[b] = 0.f;
#pragma unroll 8
            for (int k = 0; k < 128; ++k) { const float wv = w[(size_t)k * NMOD];
#pragma unroll
                for (int b = 0; b < NB; ++b) a[b] = fmaf(sv[b * 128 + k], wv, a[b]); }
            float* mp = (float*)(F.ws + WS_MODP) + ((size_t)(kc * NL + l) * NB) * NMOD + n;
#pragma unroll
            for (int b = 0; b < NB; ++b) mp[(size_t)b * NMOD] = a[b];
        }
        __syncthreads();
    }
}
__device__ __forceinline__ void pre1(Frame& F) {
    const int gt = F.vcu * (NWAVES * 64) + F.tid, NT = F.G * NWAVES * 64;
    const float* mp = (const float*)(F.ws + WS_MODP); float* mod = (float*)(F.ws + WS_MOD);
    float* av = (float*)(F.ws + WS_AV); bf16* sha = (bf16*)(F.ws + WS_SHA);
    for (int i = gt; i < NL * NB * NMOD; i += NT) { const int l = i / (NB * NMOD), b = (i / NMOD) % NB, n = i % NMOD, chunk = n >> 10, c = n & 1023;
        float s = F.in[5][l * NMOD + n];
#pragma unroll
        for (int kc = 0; kc < KSPLIT; ++kc) s += mp[(size_t)kc * NL * NB * NMOD + i];
        mod[i] = s;
        if (chunk == 1) av[((size_t)l * NB + b) * DM + c] = F.in[6][l * DM + c] * (1.0f + s);
        else if (chunk == 4) av[(size_t)NL * NB * DM + ((size_t)l * NB + b) * DM + c] = F.in[20][l * DM + c] * (1.0f + s);
        else if (chunk == 0) sha[((size_t)(l * 2 + 0) * 256 + b) * DM + c] = (bf16)f2bf(s);
        else if (chunk == 3) sha[((size_t)(l * 2 + 1) * 256 + b) * DM + c] = (bf16)f2bf(s); }
    for (int i = gt; i < NL * 2 * 246 * (DM / 8); i += NT) { const int t = i / (246 * (DM / 8)), r = i % (246 * (DM / 8));
        *(GAS v4u*)(sha + ((size_t)t * 256 + 10 + r / (DM / 8)) * DM + (r % (DM / 8)) * 8) = (v4u){0u, 0u, 0u, 0u}; }
}
__device__ __forceinline__ void h0_init(Frame& F) {
    const int gw = F.vcu * NWAVES + F.wave, NGW = F.G * NWAVES;
    const float* av = (const float*)(F.ws + WS_AV); bf16* HH = (bf16*)(F.ws + WS_HH); float* ssx = (float*)(F.ws + WS_SSX);
#pragma nounroll
    for (int r = gw; r < TG2; r += NGW) {
        const float* xrow = r < TG ? F.in[0] + (size_t)r * DM : F.in[1] + (size_t)(r - TG) * DM;
        const float* a = av + (size_t)pg8::seq_of_row(r) * DM;
        const GAS f32x4* xr = (const GAS f32x4*)xrow + F.lane;
        GAS v2u* o8 = (GAS v2u*)(HH + (size_t)r * DM) + F.lane; float s = 0.f;
#pragma unroll
        for (int j = 0; j < 4; ++j) { const f32x4 v = xr[64 * j]; const f32x4 aa = *(const f32x4*)(a + 4 * F.lane + 256 * j); const f32x4 y = v * aa;
            s += (v.x * v.x + v.y * v.y) + (v.z * v.z + v.w * v.w); o8[64 * j] = (v2u){pk2(y.x, y.y), pk2(y.z, y.w)}; }
        s = wave_sum(s);
        if (F.lane < 16) ssx[(size_t)r * 16 + F.lane] = F.lane == 0 ? s : 0.f;
    }
}
struct SguLoads { v4u gv[4]; f32x4 ss[4]; bf16x8 wf[4]; v2u uu[8]; f32x4 sg[2][2]; float bias; };
__device__ __forceinline__ void sgu_mix(Frame& F, const bf16* GV, const float* SSG, const float* sg, const bf16* Ws  , const float* bs  , bf16* U) {
    constexpr int VP = 136;
    LAS bf16* vT = (LAS bf16*)F.lds; LAS float* rq = (LAS float*)(F.lds + 128 * VP * 2);
    const int lane = F.lane, w = F.wave, tid = F.tid;
    const int NU = (TG / 128) * 8;
#define SGU_LOAD(L, it) do { const int ck_ = (it) >> 3, gi_ = (it) & 7; \
        _Pragma("unroll") for (int i = 0; i < 4; ++i) { const int q = lane + 64 * (i & 1), c8 = 8 * (w + 8 * (i >> 1)); L.gv[i] = *(const v4u*)(GV + (size_t)(ck_ * 128 + q) * DM + gi_ * 128 + c8); } \
        if (tid < 128) { _Pragma("unroll") for (int j = 0; j < 4; ++j) L.ss[j] = *(const f32x4*)(SSG + (size_t)(ck_ * 128 + tid) * 16 + 4 * j); } \
        { const int p_ = 16 * w + (lane & 15); \
          _Pragma("unroll") for (int ks = 0; ks < 4; ++ks) L.wf[ks] = *(const bf16x8*)(Ws + ((size_t)gi_ * 128 + p_) * 128 + 32 * ks + 8 * (lane >> 4)); \
          _Pragma("unroll") for (int cb = 0; cb < 8; ++cb) L.uu[cb] = *(const v2u*)(U + ((size_t)ck_ * 128 + p_) * DM + gi_ * 128 + 16 * cb + 4 * (lane >> 4)); \
          L.bias = bs[gi_ * 128 + p_]; } \
        _Pragma("unroll") for (int hf = 0; hf < 2; ++hf) { const int c8 = 8 * (w + 8 * hf); L.sg[hf][0] = *(const f32x4*)(sg + gi_ * 128 + c8); L.sg[hf][1] = *(const f32x4*)(sg + gi_ * 128 + c8 + 4); } } while (0)
#define SGU_RUN(L, it, LN, itn) do { const int ck_ = (it) >> 3, gi_ = (it) & 7; \
        __syncthreads(); \
        if (tid < 128) { const f32x4 a_ = L.ss[0], b_ = L.ss[1], c_ = L.ss[2], d_ = L.ss[3]; \
            const float s_ = ((a_[0] + a_[1]) + (a_[2] + a_[3])) + ((b_[0] + b_[1]) + (b_[2] + b_[3])) + ((c_[0] + c_[1]) + (c_[2] + c_[3])) + ((d_[0] + d_[1]) + (d_[2] + d_[3])); \
            rq[tid] = 1.0f / sqrtf(s_ * (1.0f / 1024.0f) + EPS); } \
        __syncthreads(); \
        { _Pragma("unroll") for (int i = 0; i < 4; ++i) { const int q = lane + 64 * (i & 1), c8 = 8 * (w + 8 * (i >> 1)); const v4u wv = L.gv[i]; const f32x4 g0 = L.sg[i >> 1][0], g1 = L.sg[i >> 1][1]; \
            const float gq[8] = {g0[0], g0[1], g0[2], g0[3], g1[0], g1[1], g1[2], g1[3]}; \
            const float x[8] = {bflo(wv.x), bfhi(wv.x), bflo(wv.y), bfhi(wv.y), bflo(wv.z), bfhi(wv.z), bflo(wv.w), bfhi(wv.w)}; const float r = rq[q]; \
            _Pragma("unroll") for (int j = 0; j < 8; ++j) vT[(c8 + j) * VP + q] = (bf16)f2bf(x[j] * r * gq[j]); } } \
        __syncthreads(); \
        if ((itn) < NU) SGU_LOAD(LN, itn);                           \
        f32x4 acc[8]; \
        _Pragma("unroll") for (int cb = 0; cb < 8; ++cb) acc[cb] = (f32x4){0.f, 0.f, 0.f, 0.f}; \
        _Pragma("unroll") for (int ks = 0; ks < 4; ++ks) { \
            _Pragma("unroll") for (int cb = 0; cb < 8; ++cb) { const bf16x8 afrag = *(const LAS bf16x8*)(vT + (16 * cb + (lane & 15)) * VP + 32 * ks + 8 * (lane >> 4)); \
                acc[cb] = __builtin_amdgcn_mfma_f32_16x16x32_f16(__builtin_bit_cast(h16x8, afrag), __builtin_bit_cast(h16x8, L.wf[ks]), acc[cb], 0, 0, 0); } } \
        { const int p_ = 16 * w + (lane & 15); const float bias = L.bias; \
          _Pragma("unroll") for (int cb = 0; cb < 8; ++cb) { bf16* up = U + ((size_t)ck_ * 128 + p_) * DM + gi_ * 128 + 16 * cb + 4 * (lane >> 4); const v2u uw = L.uu[cb]; \
            *(GAS v2u*)up = (v2u){pk2(bflo(uw.x) * (acc[cb][0] + bias), bfhi(uw.x) * (acc[cb][1] + bias)), pk2(bflo(uw.y) * (acc[cb][2] + bias), bfhi(uw.y) * (acc[cb][3] + bias))}; } } } while (0)
    SguLoads A, B;
    int it = F.vcu;
    if (it < NU) SGU_LOAD(A, it);
#pragma nounroll
    for (; it < NU; it += 2 * F.G) {
        SGU_RUN(A, it, B, it + F.G);
        if (it + F.G < NU) SGU_RUN(B, it + F.G, A, it + 2 * F.G);
    }
#undef SGU_LOAD
#undef SGU_RUN
    __syncthreads();
}
__device__ __forceinline__ void attn_phase(Frame& F, const bf16* Q, const bf16* K, const bf16* V, bf16* O, int nbatch, int seqlen) {
    const int nqb = seqlen / 256, nunits = nbatch * NH * nqb;
    for (int u = F.vcu; u < nunits; u += F.G) {
        const int bh = u / nqb, qb = u % nqb, b = bh / NH, h = bh % NH;
        att2::attn_unit<8>(F.wave, Q + ((size_t)bh * seqlen + qb * 256) * 96, K + (size_t)bh * seqlen * 96, V + (size_t)bh * seqlen * 64, O + ((size_t)b * seqlen + qb * 256) * 512 + h * 64, seqlen / 64, (char*)F.lds);
    }
}

constexpr int NPRE = 3, NMIX = 5, NFFN = 2, NSTEPS = NPRE + NL * (NGRP * NMIX - 1 + NFFN);
struct Args { const float* in[23]; float* out; unsigned char* ws; int s_lo, s_hi; };
__global__ void __launch_bounds__(NWAVES * 64, 2) mk_fwd(Args args) {
    extern __shared__ __attribute__((aligned(16))) unsigned char lds[];
    Frame F;
    F.lds = (LAS unsigned char*)lds;
    F.tid = threadIdx.x; F.lane = F.tid & 63; F.wave = __builtin_amdgcn_readfirstlane(F.tid >> 6);
    F.G = gridDim.x; { const int bx = blockIdx.x; F.vcu = (F.G % 8 == 0) ? (bx % 8) * (F.G / 8) + bx / 8 : bx; }
#pragma unroll
    for (int i = 0; i < 23; ++i) F.in[i] = args.in[i];
    F.out = args.out; F.ws = args.ws;
    unsigned* ctl = (unsigned*)(F.ws + WS_CTL);
    for (int u = F.tid; u < (LDS_BYTES - LDSCTL_OFF) / 4; u += NWAVES * 64) ((LAS unsigned*)(F.lds + LDSCTL_OFF))[u] = 0u;
    __syncthreads();
    const int s_lo = args.s_lo, s_hi = args.s_hi;
    XcdBarrier bar; bar.bar = ctl + CW_BAR; bar.x = 0; bar.st = nullptr;
    if (s_hi - s_lo > 1) bar = xcd_barrier_post(ctl + CW_BAR, (volatile LAS unsigned*)(F.lds + MISC_OFF) + 8);
    int step = 0;
#define RUN() (s_lo <= step && step < s_hi)
#define SEAM() do { if (step + 1 < s_hi) { xcd_barrier(bar); } } while (0)
    if (RUN()) { pre0(F); SEAM(); } ++step;
    if (RUN()) { pre1(F); SEAM(); } ++step;
    if (RUN()) { h0_init(F);
        pg8::Gemm g{(const bf16*)(F.ws + WS_SHA), (const bf16*)(F.ws + WS_WB), 256, 256, DM, DM, DM}; pg8::BiasOrder S{F.G, (int)blockIdx.x}; pg8::EpiBias E{(float*)(F.ws + WS_BIAS)};
        pg8::gemm_phase<DM, DM, DM, pg8::EpiBias, pg8::BiasOrder, true, true>(F.lds, g, S, E, F.wave); SEAM(); } ++step;
    for (int l = 0; l < NL; ++l) {
#define CTXL() int l_ = l; asm volatile("" : "+s"(l_)); Frame P = F; P.lane = lane_id_now(); P.tid = P.wave * 64 + P.lane; \
        const bf16* wb = (const bf16*)(F.ws + WS_WB + (size_t)l_ * WB_LAYER); const float* modl = (const float*)(F.ws + WS_MOD) + (size_t)l_ * NB * NMOD; \
        const float* biasl = (const float*)(F.ws + WS_BIAS) + (size_t)l_ * NB * (41 * 256); float* ssx = (float*)(F.ws + WS_SSX); bf16* HH = (bf16*)(F.ws + WS_HH); \
        const float* av1n = (const float*)(F.ws + WS_AV) + (size_t)(l_ + 1) * NB * DM; const float* av2 = (const float*)(F.ws + WS_AV) + (size_t)NL * NB * DM + (size_t)l_ * NB * DM; \
        (void)P; (void)wb; (void)modl; (void)biasl; (void)ssx; (void)HH; (void)av1n; (void)av2
        for (int grp = 0; grp < NGRP; ++grp) {
#define CTX() CTXL(); int g_ = grp; asm volatile("" : "+s"(g_)); \
            const int seqlen = g_ == 0 ? 8192 : 2048, nbatch = g_ == 0 ? 2 : 8, row_base = g_ * TG; \
            const float* xin32 = l_ == 0 ? (g_ == 0 ? F.in[0] : F.in[1]) : nullptr; bf16* x16g = (bf16*)(F.ws + WS_X16) + (size_t)g_ * TG * DM; \
            bf16* Hg = HH + (size_t)g_ * TG * DM; float* ssxg = ssx + (size_t)g_ * TG * 16; unsigned char* dsc = (unsigned char*)F.out; \
            bf16* LAT = (bf16*)(dsc + DO_LAT); bf16* U = (bf16*)(F.ws + WS_U); bf16* GV = (bf16*)(F.ws + WS_GV); bf16* SGA = (bf16*)(F.ws + WS_SGA); \
            bf16* SGB = (bf16*)(F.ws + WS_SGB); bf16* TMP = (bf16*)(F.ws + WS_TMP); \
            bf16* Qb = (bf16*)(dsc + DO_Q); bf16* Kb = (bf16*)(dsc + DO_K); bf16* Vb = (bf16*)(dsc + DO_V); bf16* Ob = (bf16*)(dsc + DO_O); float* ssl = (float*)(F.ws + WS_SSL); float* ssg = (float*)(F.ws + WS_SSG); \
            (void)seqlen; (void)nbatch; (void)row_base; (void)xin32; (void)x16g; (void)Hg; (void)ssxg; (void)LAT; (void)U; (void)GV; (void)SGA; (void)SGB; (void)TMP; (void)Qb; (void)Kb; (void)Vb; (void)Ob; (void)ssl; (void)ssg
            if (RUN()) { CTX(); pg8::Gemm g{Hg, wb + WO_IN, TG, NINP, DM, DM, DM}; pg8::StaticOrder S; S.init(TG, NINP, F.G, (int)blockIdx.x);
                LAS float* rtab = (LAS float*)(F.lds + RTAB_OFF); pg8::build_rstd_table(rtab, ssxg, S, P.tid);
                pg8::EpiProj E{LAT, U, GV, SGA, SGB, rtab, biasl, row_base, ssl, ssg};
                pg8::gemm_phase<DM, DM, DM, pg8::EpiProj, pg8::StaticOrder, true, true>(F.lds, g, S, E, F.wave); SEAM(); } ++step;
            if (RUN()) { CTX();
                { pg8::Gemm g{LAT, wb + WO_QB, TG, 1024, QLORA, LATW, QLORA}; pg8::StaticOrder S; S.init(TG, 1024, F.G, (int)blockIdx.x);
                  pg8::EpiQ E{Qb, ssl, F.in[12] + l_ * 96, (const float*)(F.ws + WS_ROPE), (const float*)(F.ws + WS_ROPE) + 8192 * 16, seqlen, att2::QSCALE};
                  pg8::gemm_phase<QLORA, LATW, QLORA, pg8::EpiQ, pg8::StaticOrder, true, true>(F.lds, g, S, E, F.wave); }
                { pg8::Gemm g{LAT + 512, wb + WO_KVB, TG, 1024, KVLORA, LATW, KVLORA}; pg8::StaticOrder S; S.init(TG, 1024, F.G, (int)blockIdx.x);
                  pg8::EpiKV E{Kb, Vb, LAT, LATW, ssl, F.in[13] + l_ * 96, (const float*)(F.ws + WS_ROPE), (const float*)(F.ws + WS_ROPE) + 8192 * 16, seqlen};
                  pg8::gemm_phase<KVLORA, LATW, KVLORA, pg8::EpiKV, pg8::StaticOrder, true, true>(F.lds, g, S, E, F.wave); }
                sgu_mix(P, GV, ssg, F.in[15] + l_ * DM, wb + WO_S, F.in[17] + l_ * 1024, U);
                SEAM(); } ++step;
            if (RUN()) { CTX(); attn_phase(P, Qb, Kb, Vb, Ob, nbatch, seqlen); SEAM(); } ++step;
            if (RUN()) { CTX();
                { pg8::Gemm g{Ob, wb + WO_OA, TG, DM, 512, 512, 512}; pg8::StaticOrder S; S.init(TG, DM, F.G, (int)blockIdx.x); pg8::EpiGate<false> E{SGA, nullptr, TMP, DM};
                  pg8::gemm_phase<512, 512, 512, pg8::EpiGate<false>, pg8::StaticOrder, true, true>(F.lds, g, S, E, F.wave); }
                { pg8::Gemm g{U, wb + WO_OB, TG, DM, DM, DM, DM}; pg8::StaticOrder S; S.init(TG, DM, F.G, (int)blockIdx.x); pg8::EpiGate<true> E{SGB, TMP, TMP, DM};
                  pg8::gemm_phase<DM, DM, DM, pg8::EpiGate<true>, pg8::StaticOrder, true, true>(F.lds, g, S, E, F.wave); }
                SEAM(); } ++step;
            if (RUN()) { CTX(); pg8::Gemm g{TMP, wb + WO_OUT, TG, DM, DM, DM, DM}; pg8::StaticOrder S; S.init(TG, DM, F.G, (int)blockIdx.x);
                pg8::EpiRes E{xin32, x16g, nullptr, x16g, modl + 2 * DM, NMOD, av2, Hg, ssxg, row_base};
                pg8::gemm_phase<DM, DM, DM, pg8::EpiRes, pg8::StaticOrder, true, true>(F.lds, g, S, E, F.wave);
                if (grp == NGRP - 1) SEAM(); }
            if (grp == NGRP - 1) ++step;
#undef CTX
        }
        if (RUN()) { CTXL(); pg8::Gemm g{HH, wb + WO_FI, TG2, 2 * DFF, DM, DM, DM}; pg8::StaticOrder S; S.init(TG2, 2 * DFF, F.G, (int)blockIdx.x);
            LAS float* rtab = (LAS float*)(F.lds + RTAB_OFF); pg8::build_rstd_table(rtab, ssx, S, P.tid);
            pg8::EpiSwiglu E{(bf16*)(F.ws + WS_ACT), DFF, rtab, biasl, 0};
            pg8::gemm_phase<DM, DM, DM, pg8::EpiSwiglu, pg8::StaticOrder, true, true>(F.lds, g, S, E, F.wave); SEAM(); } ++step;
        if (RUN()) { CTXL(); pg8::Gemm g{(const bf16*)(F.ws + WS_ACT), wb + WO_FO, TG2, DM, DFF, DFF, DFF}; pg8::StaticOrder S; S.init(TG2, DM, F.G, (int)blockIdx.x);
            bf16* x16 = (bf16*)(F.ws + WS_X16);
            pg8::EpiRes E{nullptr, x16, l_ + 1 < NL ? nullptr : F.out, x16, modl + 5 * DM, NMOD, av1n, l_ + 1 < NL ? HH : nullptr, ssx, 0};
            pg8::gemm_phase<DFF, DFF, DFF, pg8::EpiRes, pg8::StaticOrder, true, true>(F.lds, g, S, E, F.wave); SEAM(); } ++step;
#undef CTXL
    }
#undef RUN
#undef SEAM
}

extern "C" void kernel_launch(void* const* d_in, const int* in_sizes, int n_in, void* d_out, int out_size, void* d_ws, size_t ws_size, hipStream_t stream) {
    static int grid = 0;
    if (grid == 0) {
        if (n_in != 23 || out_size != NGRP * TG * DM || ws_size < WS_END) { fprintf(stderr, "kernel_launch: unexpected shapes (n_in %d, out %d, ws %zu; need ws >= %zu); nothing launched\n", n_in, out_size, ws_size, (size_t)WS_END); grid = -1; return; }
        int dev = 0, cus = 0, per_cu = 0;
        if (hipGetDevice(&dev) != hipSuccess || hipDeviceGetAttribute(&cus, hipDeviceAttributeMultiprocessorCount, dev) != hipSuccess) { grid = -1; return; }
        if (hipFuncSetAttribute((const void*)mk_fwd, hipFuncAttributeMaxDynamicSharedMemorySize, LDS_BYTES) != hipSuccess) { fprintf(stderr, "kernel_launch: hipFuncSetAttribute failed\n"); grid = -1; return; }
        if (hipOccupancyMaxActiveBlocksPerMultiprocessor(&per_cu, (const void*)mk_fwd, NWAVES * 64, LDS_BYTES) != hipSuccess || per_cu < 1) { fprintf(stderr, "kernel_launch: occupancy query reports %d\n", per_cu); }
        (void)hipGetLastError();
        if (cus < 256) { fprintf(stderr, "kernel_launch: built for a 256-CU device (the fused q / kv epilogues need one 256 x 256 unit per workgroup), found %d CUs; nothing launched\n", cus); grid = -1; return; }
        grid = 256;
    }
    if (grid < 0) return;
    if (hipMemsetAsync((char*)d_ws + WS_CTL, 0, CTL_ZERO_BYTES, stream) != hipSuccess) return;
    Args a{};
    for (int i = 0; i < 23; ++i) a.in[i] = (const float*)d_in[i];
    a.out = (float*)d_out; a.ws = (unsigned char*)d_ws;
#if MK_ONE_LAUNCH
    a.s_lo = 0; a.s_hi = NSTEPS;
    hipLaunchKernelGGL(mk_fwd, dim3(grid), dim3(NWAVES * 64), LDS_BYTES, stream, a);
#else
    for (int s = 0; s < NSTEPS; ++s) { a.s_lo = s; a.s_hi = s + 1; hipLaunchKernelGGL(mk_fwd, dim3(grid), dim3(NWAVES * 64), LDS_BYTES, stream, a); }
#endif
    const hipError_t le = hipPeekAtLastError();
    if (le != hipSuccess) fprintf(stderr, "kernel_launch: launch failed: %s\n", hipGetErrorName(le));
}
```

```cpp
#include <hip/hip_runtime.h>
#include <cstdio>
#include <cstdint>
namespace pg8 {
#define PG8_LAS __attribute__((address_space(3)))
typedef unsigned short bf16_t;
typedef _Float16 bf16x8 __attribute__((ext_vector_type(8)));
typedef float f32x4 __attribute__((ext_vector_type(4)));
typedef unsigned u32x4 __attribute__((ext_vector_type(4)));
constexpr int BM = 256, BK = 64, HALF = 128, HTB = HALF * BK * 2  , STAGE_BYTES = 8 * HTB, NXCD = 8, WGM = 8;

__host__ __device__ __forceinline__ int lds_byte(int r, int c) { const int st = (r >> 4) * 2 + (c >> 5), rr = r & 15, cc = c & 31, ob = rr * 64 + cc * 2; return st * 1024 + (ob ^ (((ob >> 9) & 1) << 5)); }
__host__ __device__ __forceinline__ void stage_rc(int b, int& R, int& C) { const int st = b / 1024, sb = b % 1024, swz = sb ^ (((sb >> 9) & 1) << 5); R = (st >> 1) * 16 + swz / 64; C = (st & 1) * 32 + (swz % 64) / 2; }
__host__ __device__ __forceinline__ int perm32(int rho) { const int n = rho >> 4, i = rho & 15; return 8 * (i >> 2) + 4 * n + (i & 3); }

struct Unit { int pm, pn, idx; };
struct Gemm { const bf16_t* A; const bf16_t* Bt; int M, N, K, lda, ldb; };

struct StaticOrder {
    int nM, nN, nwg, G, c, i0 = 0, i1 = 1 << 20;
    __host__ __device__ void init(int M, int N, int G_, int c_) { nM = M / BM; nN = N / BM; nwg = nM * nN; G = G_; c = c_; }
    __host__ __device__ bool next(int i, Unit& u) const {
        if (i + i0 >= i1) return false;
        const long L = (long)(i + i0) * G + c; if (L >= nwg) return false;
        int wgid = (int)L; { const int q = nwg / NXCD, r = nwg % NXCD, xcd = wgid % NXCD, off = wgid / NXCD; wgid = (xcd < r ? xcd * (q + 1) : r * (q + 1) + (xcd - r) * q) + off; }
        const int nig = WGM * nN, gid = wgid / nig, fm = gid * WGM, gsz = (nM - fm) < WGM ? (nM - fm) : WGM;
        u.pm = fm + ((wgid % nig) % gsz); u.pn = (wgid % nig) / gsz; u.idx = i; return true;
    }
    __device__ __forceinline__ void a_ready(const Unit&) const {}
    __device__ __forceinline__ void done(const Unit&) const {}
};

__device__ __forceinline__ unsigned cvt_pk_bf16(float lo, float hi) { unsigned r; asm volatile("v_cvt_pk_f16_f32 %0, %1, %2" : "=v"(r) : "v"(lo), "v"(hi)); return r; }
typedef float f32x2 __attribute__((ext_vector_type(2)));

typedef _Float16 h16x2 __attribute__((ext_vector_type(2)));
__device__ __forceinline__ float bf_lo(unsigned w) { return (float)__builtin_bit_cast(h16x2, w)[0]; }
__device__ __forceinline__ float bf_hi(unsigned w) { return (float)__builtin_bit_cast(h16x2, w)[1]; }
__device__ __forceinline__ float fast_sigmoid(float x) { return __builtin_amdgcn_rcpf(1.0f + __builtin_amdgcn_exp2f(x * -1.4426950408889634f)); }
__device__ __forceinline__ float gelu_tanh(float x) { const float y = x * (0.7978845608028654f + 0.035677408136300125f * x * x); return x * __builtin_amdgcn_rcpf(1.0f + __builtin_amdgcn_exp2f(y * -2.8853900817779268f)); }
#ifndef PG8_WT
#define PG8_WT 0
#endif
__device__ __forceinline__ void st16(bf16_t* base, size_t elem_off, const u32x4 v) {
#if PG8_WT
    __amdgpu_buffer_rsrc_t r = __builtin_amdgcn_make_buffer_rsrc((void*)base, 0, 0x7FFFFFFF, 0x00020000);
    __builtin_amdgcn_raw_buffer_store_b128(v, r, (unsigned)(elem_off * 2), 0, 16);
#else
    *(u32x4*)(base + elem_off) = v;
#endif
}
__device__ __forceinline__ u32x4 pack8(const f32x4 v0, const f32x4 v1) { u32x4 w; w.x = cvt_pk_bf16(v0[0], v0[1]); w.y = cvt_pk_bf16(v0[2], v0[3]); w.z = cvt_pk_bf16(v1[0], v1[1]); w.w = cvt_pk_bf16(v1[2], v1[3]); return w; }


__device__ __forceinline__ float row_rstd16(const float* slots, float inv_n, float eps) {
    const f32x4 a = *(const f32x4*)(slots), b = *(const f32x4*)(slots + 4), c = *(const f32x4*)(slots + 8), d = *(const f32x4*)(slots + 12);
    const float s = ((a[0] + a[1]) + (a[2] + a[3])) + ((b[0] + b[1]) + (b[2] + b[3])) + ((c[0] + c[1]) + (c[2] + c[3])) + ((d[0] + d[1]) + (d[2] + d[3]));
    return 1.0f / sqrtf(s * inv_n + eps);
}
template <class Sched> __device__ __forceinline__ void build_rstd_table(PG8_LAS float* tab, const float* slots, const Sched& S, int tid) {
    int nr = 0; { Unit u; while (nr < 12 && S.next(nr, u)) ++nr; }
    for (int idx = tid; idx < nr * 256; idx += 512) { Unit u; S.next(idx >> 8, u); tab[idx] = row_rstd16(slots + ((size_t)u.pm * BM + (idx & 255)) * 16, 1.0f / 1024.0f, 1e-6f); }
    __syncthreads();
}
__device__ __forceinline__ float sum_fq(float v) {
    v += __int_as_float(__builtin_amdgcn_ds_swizzle(__float_as_int(v), 0x401F));
    auto rr = __builtin_amdgcn_permlane32_swap(__float_as_uint(v), __float_as_uint(v), false, false);
    return __uint_as_float(rr[0]) + __uint_as_float(rr[1]);
}
__device__ __forceinline__ int seq_of_row(int r) { return r < 16384 ? (r >> 13) : 2 + ((r - 16384) >> 11); }

struct EpiPlain {
    static constexpr bool PERM = true, AFTER_DRAIN = false;
    bf16_t* O; int ldc;
    __device__ __forceinline__ void operator()(const f32x4 (&acc)[2][2][4][2], const Unit& u, int wr, int wc, int fr, int fq) const {
        const int row0 = u.pm * BM + wr * 64 + fr, col0 = u.pn * BM + wc * 32 + 8 * fq;
#pragma unroll
        for (int ai = 0; ai < 2; ++ai)
#pragma unroll
            for (int m = 0; m < 4; ++m) { const size_t roff = (size_t)(row0 + ai * HALF + m * 16) * ldc + col0;
#pragma unroll
                for (int bj = 0; bj < 2; ++bj) st16(O, roff + bj * HALF, pack8(acc[ai][bj][m][0], acc[ai][bj][m][1])); }
    }
};
struct EpiProj {
    static constexpr bool PERM = true, AFTER_DRAIN = false;
    bf16_t *LAT, *U, *GV, *SGA, *SGB;
    const PG8_LAS float* rtab;
    const float* bias;
    int row_base;
    float* ssl;
    float* ssg;
    __device__ __forceinline__ void operator()(const f32x4 (&acc)[2][2][4][2], const Unit& u, int wr, int wc, int fr, int fq) const {
        const int pn = u.pn; bf16_t* base; int ldc, colt, act;
        float* sp = nullptr; int slot = 0;
        if (pn == 0) { sp = ssl; slot = wc; } else if (pn == 1) { sp = ssl; slot = 4 + wc; } else if (pn == 2) { sp = ssl; slot = 8 + wc; } else if (pn >= 7 && pn < 11) { sp = ssg; slot = 4 * (pn - 7) + wc; }
        if (pn < 3) { base = LAT; ldc = 768; colt = pn * BM; act = 0; }
        else if (pn < 7) { base = U; ldc = 1024; colt = (pn - 3) * BM; act = 1; }
        else if (pn < 11) { base = GV; ldc = 1024; colt = (pn - 7) * BM; act = 1; }
        else if (pn < 15) { base = SGA; ldc = 1024; colt = (pn - 11) * BM; act = 2; }
        else { base = SGB; ldc = 1024; colt = (pn - 15) * BM; act = 2; }
        const int row0 = u.pm * BM + wr * 64 + fr, col0 = colt + wc * 32 + 8 * fq;
        const float* bp = bias + (size_t)seq_of_row(row_base + u.pm * BM) * (41 * 256) + pn * BM + wc * 32 + 8 * fq;
        f32x4 bv[2][2];
#pragma unroll
        for (int bj = 0; bj < 2; ++bj)
#pragma unroll
            for (int n = 0; n < 2; ++n) bv[bj][n] = *(const f32x4*)(bp + bj * HALF + 4 * n);
#pragma unroll
        for (int ai = 0; ai < 2; ++ai)
#pragma unroll
            for (int m = 0; m < 4; ++m) { const int row = row0 + ai * HALF + m * 16; const size_t roff = (size_t)row * ldc + col0;
                const float rs = rtab[u.idx * 256 + (row - u.pm * BM)]; float ss = 0.f;
#pragma unroll
                for (int bj = 0; bj < 2; ++bj) { f32x4 v0 = acc[ai][bj][m][0] * rs + bv[bj][0], v1 = acc[ai][bj][m][1] * rs + bv[bj][1];
                    if (act == 1) {
#pragma unroll
                        for (int j = 0; j < 4; ++j) { v0[j] = gelu_tanh(v0[j]); v1[j] = gelu_tanh(v1[j]); } }
                    else if (act == 2) {
#pragma unroll
                        for (int j = 0; j < 4; ++j) { v0[j] = fast_sigmoid(v0[j]); v1[j] = fast_sigmoid(v1[j]); } }
                    if (bj == 0 || pn != 1) ss += ((v0[0] * v0[0] + v0[1] * v0[1]) + (v0[2] * v0[2] + v0[3] * v0[3])) + ((v1[0] * v1[0] + v1[1] * v1[1]) + (v1[2] * v1[2] + v1[3] * v1[3]));
                    st16(base, roff + bj * HALF, pack8(v0, v1)); }
                if (sp) { ss = sum_fq(ss); if (fq == 0) sp[(size_t)row * 16 + slot] = ss; } }
    }
};
template <bool ADD> struct EpiGate {
    static constexpr bool PERM = true, AFTER_DRAIN = false;
    const bf16_t* G; const bf16_t* T; bf16_t* O; int ldc;
    __device__ __forceinline__ void operator()(const f32x4 (&acc)[2][2][4][2], const Unit& u, int wr, int wc, int fr, int fq) const {
        const int row0 = u.pm * BM + wr * 64 + fr, col0 = u.pn * BM + wc * 32 + 8 * fq;
#pragma unroll
        for (int am = 0; am < 2; ++am) { const int ai = am;
            u32x4 gq[4][2], tq[4][2];
#pragma unroll
            for (int m = 0; m < 4; ++m) { const size_t off = (size_t)(row0 + ai * HALF + m * 16) * ldc + col0;
#pragma unroll
                for (int bj = 0; bj < 2; ++bj) { gq[m][bj] = *(const u32x4*)(G + off + bj * HALF); if (ADD) tq[m][bj] = *(const u32x4*)(T + off + bj * HALF); } }
            asm volatile("" ::: "memory");
#pragma unroll
            for (int m = 0; m < 4; ++m) { const size_t off = (size_t)(row0 + ai * HALF + m * 16) * ldc + col0;
#pragma unroll
                for (int bj = 0; bj < 2; ++bj) { f32x4 v0 = acc[ai][bj][m][0], v1 = acc[ai][bj][m][1];
                    const u32x4 g = gq[m][bj];
                    v0[0] *= bf_lo(g.x); v0[1] *= bf_hi(g.x); v0[2] *= bf_lo(g.y); v0[3] *= bf_hi(g.y); v1[0] *= bf_lo(g.z); v1[1] *= bf_hi(g.z); v1[2] *= bf_lo(g.w); v1[3] *= bf_hi(g.w);
                    if (ADD) { const u32x4 t = tq[m][bj];
                        v0[0] += bf_lo(t.x); v0[1] += bf_hi(t.x); v0[2] += bf_lo(t.y); v0[3] += bf_hi(t.y); v1[0] += bf_lo(t.z); v1[1] += bf_hi(t.z); v1[2] += bf_lo(t.w); v1[3] += bf_hi(t.w); }
                    st16(O, off + bj * HALF, pack8(v0, v1)); } }
            asm volatile("" ::: "memory"); }
    }
};
struct EpiRes {
    static constexpr bool PERM = true, AFTER_DRAIN = false;
    const float* XI32; const bf16_t* XI16; float* XO32; bf16_t* XO16; const float* gate; int gld; const float* av; bf16_t* HO; float* SS; int row_base;
    __device__ __forceinline__ void operator()(const f32x4 (&acc)[2][2][4][2], const Unit& u, int wr, int wc, int fr, int fq) const {
        const int row0 = u.pm * BM + wr * 64 + fr, col0 = u.pn * BM + wc * 32 + 8 * fq;
        const int sq = seq_of_row(row_base + u.pm * BM);
        const float* gv = gate + (size_t)sq * gld + col0;
        f32x4 g[2][2], a[2][2];
#pragma unroll
        for (int bj = 0; bj < 2; ++bj)
#pragma unroll
            for (int n = 0; n < 2; ++n) { g[bj][n] = *(const f32x4*)(gv + bj * HALF + 4 * n); a[bj][n] = HO ? *(const f32x4*)(av + (size_t)sq * 1024 + col0 + bj * HALF + 4 * n) : (f32x4){0.f, 0.f, 0.f, 0.f}; }
#pragma unroll
        for (int am = 0; am < 4; ++am) { const int ai = am >> 1, m0 = (am & 1) * 2;
            f32x4 xq[2][2][2];
            if (XI32) {
#pragma unroll
                for (int mm = 0; mm < 2; ++mm) { const size_t off = (size_t)(row0 + ai * HALF + (m0 + mm) * 16) * 1024 + col0;
#pragma unroll
                    for (int bj = 0; bj < 2; ++bj)
#pragma unroll
                        for (int n = 0; n < 2; ++n) xq[mm][bj][n] = *(const f32x4*)(XI32 + off + bj * HALF + 4 * n); }
            } else {
                u32x4 xh[2][2];
#pragma unroll
                for (int mm = 0; mm < 2; ++mm) { const size_t off = (size_t)(row0 + ai * HALF + (m0 + mm) * 16) * 1024 + col0;
#pragma unroll
                    for (int bj = 0; bj < 2; ++bj) xh[mm][bj] = *(const u32x4*)(XI16 + off + bj * HALF); }
#pragma unroll
                for (int mm = 0; mm < 2; ++mm)
#pragma unroll
                    for (int bj = 0; bj < 2; ++bj) { const u32x4 w = xh[mm][bj]; xq[mm][bj][0] = (f32x4){bf_lo(w.x), bf_hi(w.x), bf_lo(w.y), bf_hi(w.y)}; xq[mm][bj][1] = (f32x4){bf_lo(w.z), bf_hi(w.z), bf_lo(w.w), bf_hi(w.w)}; }
            }
            asm volatile("" ::: "memory");
#pragma unroll
            for (int mm = 0; mm < 2; ++mm) { const int m = m0 + mm; const int row = row0 + ai * HALF + m * 16; const size_t off = (size_t)row * 1024 + col0; float ss = 0.f;
#pragma unroll
                for (int bj = 0; bj < 2; ++bj) { f32x4 x[2];
#pragma unroll
                    for (int n = 0; n < 2; ++n) { x[n] = xq[mm][bj][n] + g[bj][n] * acc[ai][bj][m][n];
                        ss += (x[n][0] * x[n][0] + x[n][1] * x[n][1]) + (x[n][2] * x[n][2] + x[n][3] * x[n][3]); }
                    if (XO32) { *(f32x4*)(XO32 + off + bj * HALF) = x[0]; *(f32x4*)(XO32 + off + bj * HALF + 4) = x[1]; }
                    else st16(XO16, off + bj * HALF, pack8(x[0], x[1]));
                    if (HO) st16(HO, off + bj * HALF, pack8(x[0] * a[bj][0], x[1] * a[bj][1])); }
                if (HO) { ss = sum_fq(ss); if (fq == 0) SS[(size_t)row * 16 + u.pn * 4 + wc] = ss; } }
            asm volatile("" ::: "memory"); }
    }
};
struct EpiSwiglu {
    static constexpr bool PERM = true, AFTER_DRAIN = false;
    bf16_t* O; int ldc; const PG8_LAS float* rtab; const float* bias  ; int row_base;
    __device__ __forceinline__ void operator()(const f32x4 (&acc)[2][2][4][2], const Unit& u, int wr, int wc, int fr, int fq) const {
        const int row0 = u.pm * BM + wr * 64 + fr, col0 = u.pn * HALF + wc * 32 + 8 * fq;
        const float* bp = bias + (size_t)seq_of_row(row_base + u.pm * BM) * (41 * 256) + (19 + u.pn) * BM + wc * 32 + 8 * fq;
        f32x4 bv[2][2];
#pragma unroll
        for (int bj = 0; bj < 2; ++bj)
#pragma unroll
            for (int n = 0; n < 2; ++n) bv[bj][n] = *(const f32x4*)(bp + bj * HALF + 4 * n);
#pragma unroll
        for (int ai = 0; ai < 2; ++ai)
#pragma unroll
            for (int m = 0; m < 4; ++m) { const int row = row0 + ai * HALF + m * 16; f32x4 o[2];
                const float rs = rtab[u.idx * 256 + (row - u.pm * BM)];
#pragma unroll
                for (int n = 0; n < 2; ++n)
#pragma unroll
                    for (int j = 0; j < 4; ++j) { const float up = acc[ai][0][m][n][j] * rs + bv[0][n][j], gt = acc[ai][1][m][n][j] * rs + bv[1][n][j]; o[n][j] = up * gt * fast_sigmoid(gt); }
                st16(O, (size_t)row * ldc + col0, pack8(o[0], o[1])); }
    }
};
__device__ __forceinline__ float bf_lo2(unsigned w) { return bf_lo(w); }
__device__ __forceinline__ void stage_tile_f16(const f32x4 (&acc)[2][2][4][2], PG8_LAS unsigned char* lds, int wr, int wc, int fr, int fq) {
#pragma unroll
    for (int ai = 0; ai < 2; ++ai)
#pragma unroll
        for (int m = 0; m < 4; ++m) { const int row = ai * HALF + wr * 64 + m * 16 + fr;
#pragma unroll
            for (int bj = 0; bj < 2; ++bj) { const int chunk = bj * 16 + wc * 4 + fq;
                *(PG8_LAS u32x4*)(lds + row * 512 + ((chunk ^ (row & 31)) << 4)) = pack8(acc[ai][bj][m][0], acc[ai][bj][m][1]); } }
    asm volatile("s_waitcnt lgkmcnt(0)" ::: "memory"); __builtin_amdgcn_s_barrier(); asm volatile("" ::: "memory");
}
__device__ __forceinline__ u32x4 tile_chunk(const PG8_LAS unsigned char* lds, int row, int chunk) { return *(const PG8_LAS u32x4*)(lds + row * 512 + ((chunk ^ (row & 31)) << 4)); }
__device__ __forceinline__ void unpack8h(const u32x4 w, float (&o)[8]) { o[0] = bf_lo(w.x); o[1] = bf_hi(w.x); o[2] = bf_lo(w.y); o[3] = bf_hi(w.y); o[4] = bf_lo(w.z); o[5] = bf_hi(w.z); o[6] = bf_lo(w.w); o[7] = bf_hi(w.w); }
__device__ __forceinline__ u32x4 pack8h(const float (&x)[8]) { u32x4 w; w.x = cvt_pk_bf16(x[0], x[1]); w.y = cvt_pk_bf16(x[2], x[3]); w.z = cvt_pk_bf16(x[4], x[5]); w.w = cvt_pk_bf16(x[6], x[7]); return w; }
__device__ __forceinline__ void head_norm_rope_store(const u32x4 (&w)[12], const float pre_nope, const float pre_rope, const float oscale, const float* g, const float* rc, const float* rs, bf16_t* dbase, const size_t doff) {
    float s = 0.f;
#pragma unroll
    for (int j = 0; j < 12; ++j) { float x[8]; unpack8h(w[j], x); const float p = j < 8 ? pre_nope : pre_rope;
#pragma unroll
        for (int i = 0; i < 8; ++i) { const float y = x[i] * p; s += y * y; } }
    const float r = 1.0f / sqrtf(s * (1.f / 96.f) + 1e-6f);
    const float rn = r * pre_nope * oscale, rr = r * pre_rope * oscale;
#pragma unroll
    for (int j = 0; j < 8; ++j) { float x[8]; unpack8h(w[j], x);
#pragma unroll
        for (int i = 0; i < 8; ++i) x[i] = (x[i] * rn) * g[8 * j + i];
        st16(dbase, doff + 8 * j, pack8h(x)); }
#pragma unroll
    for (int jj = 0; jj < 2; ++jj) { float x1[8], x2[8], o1[8], o2[8]; unpack8h(w[8 + jj], x1); unpack8h(w[10 + jj], x2);
        const f32x4 ca = *(const f32x4*)(rc + 8 * jj), cb = *(const f32x4*)(rc + 8 * jj + 4), sa = *(const f32x4*)(rs + 8 * jj), sb = *(const f32x4*)(rs + 8 * jj + 4);
        const float c[8] = {ca[0], ca[1], ca[2], ca[3], cb[0], cb[1], cb[2], cb[3]}, sn[8] = {sa[0], sa[1], sa[2], sa[3], sb[0], sb[1], sb[2], sb[3]};
#pragma unroll
        for (int i = 0; i < 8; ++i) { const float a = (x1[i] * rr) * g[64 + 8 * jj + i], b = (x2[i] * rr) * g[80 + 8 * jj + i]; o1[i] = a * c[i] - b * sn[i]; o2[i] = b * c[i] + a * sn[i]; }
        st16(dbase, doff + 64 + 8 * jj, pack8h(o1)); st16(dbase, doff + 80 + 8 * jj, pack8h(o2)); }
}
struct EpiQ {
    static constexpr bool PERM = true, AFTER_DRAIN = true;
    bf16_t* Q; const float* ssl; const float* g; const float* rc0; const float* rs0; int seqlen; float qscale;
    __device__ __forceinline__ void operator()(const f32x4 (&)[2][2][4][2], const Unit&, int, int, int, int) const {}
    __device__ __forceinline__ void fused(const f32x4 (&acc)[2][2][4][2], const Unit& u, int wr, int wc, int fr, int fq, PG8_LAS unsigned char* lds, int wid, int lane) const {
        stage_tile_f16(acc, lds, wr, wc, fr, fq);
        const int tid = wid * 64 + lane, row = tid & 255, hh = tid >> 8, t = u.pm * BM + row, head = 2 * u.pn + hh, b = t / seqlen, s = t - b * seqlen;
        u32x4 w[12];
#pragma unroll
        for (int j = 0; j < 12; ++j) w[j] = tile_chunk(lds, row, 16 * hh + j);
        const f32x4 sa = *(const f32x4*)(ssl + (size_t)t * 16), sb = *(const f32x4*)(ssl + (size_t)t * 16 + 4);
        const float rq = 1.0f / sqrtf((((sa[0] + sa[1]) + (sa[2] + sa[3])) + ((sb[0] + sb[1]) + (sb[2] + sb[3]))) * (1.f / 384.f) + 1e-6f);
        head_norm_rope_store(w, rq, rq, qscale, g, rc0 + s * 16, rs0 + s * 16, Q, ((size_t)(b * 8 + head) * seqlen + s) * 96);
        asm volatile("s_waitcnt lgkmcnt(0)" ::: "memory"); __builtin_amdgcn_s_barrier(); asm volatile("" ::: "memory");
    }
};
struct EpiKV {
    static constexpr bool PERM = true, AFTER_DRAIN = true;
    bf16_t* K; bf16_t* V; const bf16_t* LAT; int latw; const float* ssl; const float* g; const float* rc0; const float* rs0; int seqlen;
    __device__ __forceinline__ void operator()(const f32x4 (&)[2][2][4][2], const Unit&, int, int, int, int) const {}
    __device__ __forceinline__ void fused(const f32x4 (&acc)[2][2][4][2], const Unit& u, int wr, int wc, int fr, int fq, PG8_LAS unsigned char* lds, int wid, int lane) const {
        stage_tile_f16(acc, lds, wr, wc, fr, fq);
        const int tid = wid * 64 + lane, row = tid & 255, hh = tid >> 8, t = u.pm * BM + row, head = 2 * u.pn + hh, b = t / seqlen, s = t - b * seqlen;
        const size_t orow = (size_t)(b * 8 + head) * seqlen + s;
        const f32x4 sk = *(const f32x4*)(ssl + (size_t)t * 16 + 8);
        const float rkv = 1.0f / sqrtf(((sk[0] + sk[1]) + (sk[2] + sk[3])) * (1.f / 256.f) + 1e-6f);
        u32x4 w[12];
#pragma unroll
        for (int j = 0; j < 8; ++j) w[j] = tile_chunk(lds, row, 16 * hh + j);
#pragma unroll
        for (int j = 0; j < 4; ++j) w[8 + j] = *(const u32x4*)(LAT + (size_t)t * latw + 384 + 8 * j);
        head_norm_rope_store(w, rkv, 1.0f, 1.0f, g, rc0 + s * 16, rs0 + s * 16, K, orow * 96);
#pragma unroll
        for (int j = 0; j < 8; ++j) { float x[8]; unpack8h(tile_chunk(lds, row, 16 * hh + 8 + j), x);
#pragma unroll
            for (int i = 0; i < 8; ++i) x[i] *= rkv;
            st16(V, orow * 64 + 8 * j, pack8h(x)); }
        asm volatile("s_waitcnt lgkmcnt(0)" ::: "memory"); __builtin_amdgcn_s_barrier(); asm volatile("" ::: "memory");
    }
};
struct EpiBias {
    static constexpr bool PERM = true, AFTER_DRAIN = false;
    float* B;
    __device__ __forceinline__ void operator()(const f32x4 (&acc)[2][2][4][2], const Unit& u, int wr, int wc, int fr, int fq) const {
        if (wr != 0 || fr >= 10) return;
        const int l = u.pm >> 1, j = u.pn - l * 65;
        float* dst = B + ((size_t)l * 10 + fr) * (41 * 256) + j * BM + wc * 32 + 8 * fq;
#pragma unroll
        for (int bj = 0; bj < 2; ++bj)
#pragma unroll
            for (int n = 0; n < 2; ++n) *(f32x4*)(dst + bj * HALF + 4 * n) = acc[0][bj][0][n];
    }
};
struct BiasOrder {
    int G, c;
    __device__ __forceinline__ bool next(int i, Unit& u) const { const int L = i * G + c; if (L >= 4 * 41) return false; const int l = L / 41, j = L % 41; u.pm = 2 * l + (j >= 19 ? 1 : 0); u.pn = l * 65 + j; u.idx = i; return true; }
    __device__ __forceinline__ void a_ready(const Unit&) const {}
    __device__ __forceinline__ void done(const Unit&) const {}
};

template <int K, int LDA, int LDB, class Epi, class Sched, bool ALIGN_EPI = false, bool SP2 = false>
__device__ __forceinline__ void gemm_phase(PG8_LAS unsigned char* lds, const Gemm g, const Sched& S, const Epi& E, const int wave_sgpr) {
    int lane_; asm volatile("v_mbcnt_lo_u32_b32 %0, -1, 0\n\tv_mbcnt_hi_u32_b32 %0, -1, %0" : "=v"(lane_));
    const int wid = wave_sgpr, lane = lane_, tid = wid * 64 + lane, wr = wid >> 2, wc = wid & 3, fr = lane & 15, fq = lane >> 4;
    constexpr int nt = K / BK; static_assert(K % (2 * BK) == 0 && nt >= 2, "K must be a multiple of 128");
    unsigned voffA[2], voffB[2];
#pragma unroll
    for (int i = 0; i < 2; ++i) { int R, C; stage_rc(tid * 16 + i * 8192, R, C); const int Rb = Epi::PERM ? ((R & ~31) + perm32(R & 31)) : R;
        voffA[i] = (unsigned)(R * LDA + C) * 2u; voffB[i] = (unsigned)(Rb * LDB + C) * 2u; }
    const size_t kstep = (size_t)(BK * 2);
    const size_t hstepA = (size_t)HALF * LDA * 2, hstepB = (size_t)HALF * LDB * 2;
    const size_t tstepA = 2 * hstepA, tstepB = 2 * hstepB;
    const unsigned ldsw = (unsigned)wid * 1024u;
    const int aoff = lds_byte(wr * 64 + fr, fq * 8), boff = lds_byte(wc * 32 + fr, fq * 8);
#define PG8_SA(b, h) (((b) * 2 + (h)) * HTB)
#define PG8_SB(b, h) ((4 + (b) * 2 + (h)) * HTB)
#define PG8_STAGE(bufoff, gbase, voff) do { _Pragma("unroll") for (int _i = 0; _i < 2; ++_i) \
        __builtin_amdgcn_global_load_lds((const unsigned*)((const char*)(gbase) + (voff)[_i]), (PG8_LAS unsigned*)(lds + (bufoff) + ldsw + _i * 8192), 16, 0, 0); } while (0)
#define PG8_LDA(dst, b, h) do { _Pragma("unroll") for (int m = 0; m < 4; ++m) _Pragma("unroll") for (int k = 0; k < 2; ++k) dst[m][k] = *(const PG8_LAS bf16x8*)(lds + PG8_SA(b, h) + aoff + m * 2048 + k * 1024); } while (0)
#define PG8_LDB(dst, b, h) do { _Pragma("unroll") for (int n = 0; n < 2; ++n) _Pragma("unroll") for (int k = 0; k < 2; ++k) dst[n][k] = *(const PG8_LAS bf16x8*)(lds + PG8_SB(b, h) + boff + n * 2048 + k * 1024); } while (0)
#define PG8_MMA(ai, bj, At, Bt) do { __builtin_amdgcn_s_setprio(1); _Pragma("unroll") for (int m = 0; m < 4; ++m) _Pragma("unroll") for (int n = 0; n < 2; ++n) _Pragma("unroll") for (int k = 0; k < 2; ++k) \
        acc[ai][bj][m][n] = __builtin_amdgcn_mfma_f32_16x16x32_f16(Bt[n][k], At[m][k], acc[ai][bj][m][n], 0, 0, 0); __builtin_amdgcn_s_setprio(0); } while (0)
#define PG8_WAIT_V(n) asm volatile("s_waitcnt vmcnt(" #n ")" ::: "memory")
#define PG8_WAIT_L(n) asm volatile("s_waitcnt lgkmcnt(" #n ")" ::: "memory")
#define PG8_BAR __builtin_amdgcn_s_barrier()
#define PG8_SCHED __builtin_amdgcn_sched_barrier(0)
    Unit cur, nxt; int ui = 0;
    if (!S.next(0, cur)) return;
    f32x4 acc[2][2][4][2];
#pragma unroll
    for (int a = 0; a < 2; ++a)
#pragma unroll
        for (int b = 0; b < 2; ++b)
#pragma unroll
            for (int m = 0; m < 4; ++m)
#pragma unroll
                for (int n = 0; n < 2; ++n) acc[a][b][m][n] = (f32x4){0.f, 0.f, 0.f, 0.f};
    bf16x8 At[4][2], B0[2][2], B1[2][2];
    const char* cA = (const char*)g.A + (size_t)cur.pm * tstepA; const char* cB = (const char*)g.Bt + (size_t)cur.pn * tstepB;
    S.a_ready(cur);
    if constexpr (SP2) {
        PG8_STAGE(PG8_SB(0, 0), cB, voffB); PG8_STAGE(PG8_SB(0, 1), cB + hstepB, voffB); PG8_STAGE(PG8_SA(0, 0), cA, voffA); PG8_STAGE(PG8_SA(0, 1), cA + hstepA, voffA);
        if (wr == 1) PG8_BAR;
        PG8_WAIT_V(2); PG8_BAR;
        PG8_STAGE(PG8_SB(1, 0), cB + kstep, voffB); PG8_STAGE(PG8_SA(1, 0), cA + kstep, voffA); PG8_STAGE(PG8_SB(1, 1), cB + hstepB + kstep, voffB);
        PG8_WAIT_V(6); PG8_BAR;
    } else {
        PG8_STAGE(PG8_SB(0, 0), cB, voffB); PG8_STAGE(PG8_SA(0, 0), cA, voffA); PG8_STAGE(PG8_SB(0, 1), cB + hstepB, voffB); PG8_STAGE(PG8_SA(0, 1), cA + hstepA, voffA);
        if (wr == 1) PG8_BAR;
        PG8_WAIT_V(4); PG8_BAR;
        PG8_STAGE(PG8_SB(1, 0), cB + kstep, voffB); PG8_STAGE(PG8_SA(1, 0), cA + kstep, voffA); PG8_STAGE(PG8_SB(1, 1), cB + hstepB + kstep, voffB);
        PG8_WAIT_V(6); PG8_BAR;
    }
    for (;;) {
        const bool has_next = S.next(ui + 1, nxt);
        const char* nA = has_next ? (const char*)g.A + (size_t)nxt.pm * tstepA : cA; const char* nB = has_next ? (const char*)g.Bt + (size_t)nxt.pn * tstepB : cB;
#pragma nounroll
        for (int t = 0; t < nt; t += 2) {
            const bool last = (t == nt - 2);
            const char* a1 = cA + (size_t)(t + 1) * kstep;
            const char* a2 = last ? nA : cA + (size_t)(t + 2) * kstep; const char* b2 = last ? nB : cB + (size_t)(t + 2) * kstep;
            const char* a3 = a2 + kstep; const char* b3 = b2 + kstep;
            if (last && has_next) S.a_ready(nxt);
            if constexpr (SP2) {
            PG8_LDB(B0, 0, 0); PG8_LDB(B1, 0, 1); PG8_SCHED; PG8_LDA(At, 0, 0); PG8_STAGE(PG8_SA(1, 1), a1 + hstepA, voffA);
            PG8_WAIT_V(8); PG8_WAIT_L(0); PG8_BAR; PG8_MMA(0, 0, At, B0); PG8_MMA(0, 1, At, B1); PG8_BAR; PG8_SCHED;
            PG8_LDA(At, 0, 1); PG8_STAGE(PG8_SB(0, 0), b2, voffB); PG8_STAGE(PG8_SB(0, 1), b2 + hstepB, voffB); PG8_STAGE(PG8_SA(0, 0), a2, voffA);
            PG8_WAIT_V(8); PG8_WAIT_L(0); PG8_BAR; PG8_MMA(1, 0, At, B0); PG8_MMA(1, 1, At, B1); PG8_BAR; PG8_SCHED;
            PG8_LDB(B0, 1, 0); PG8_LDB(B1, 1, 1); PG8_SCHED; PG8_LDA(At, 1, 0); PG8_STAGE(PG8_SA(0, 1), a2 + hstepA, voffA);
            PG8_WAIT_V(8); PG8_WAIT_L(0); PG8_BAR; PG8_MMA(0, 0, At, B0); PG8_MMA(0, 1, At, B1); PG8_BAR; PG8_SCHED;
            PG8_LDA(At, 1, 1); PG8_STAGE(PG8_SB(1, 0), b3, voffB); PG8_STAGE(PG8_SB(1, 1), b3 + hstepB, voffB); PG8_STAGE(PG8_SA(1, 0), a3, voffA);
            PG8_WAIT_V(8); PG8_WAIT_L(0); PG8_BAR; PG8_MMA(1, 0, At, B0); PG8_MMA(1, 1, At, B1); PG8_BAR; PG8_SCHED;
            } else {
            PG8_LDB(B0, 0, 0); PG8_SCHED; PG8_LDA(At, 0, 0); PG8_STAGE(PG8_SA(1, 1), a1 + hstepA, voffA);
            PG8_WAIT_L(8); PG8_BAR; PG8_WAIT_L(0); PG8_MMA(0, 0, At, B0); PG8_BAR; PG8_SCHED;
            PG8_LDB(B1, 0, 1); PG8_STAGE(PG8_SB(0, 0), b2, voffB);
            PG8_BAR; PG8_WAIT_L(0); PG8_MMA(0, 1, At, B1); PG8_BAR;
            PG8_LDA(At, 0, 1); PG8_STAGE(PG8_SA(0, 0), a2, voffA);
            PG8_BAR; PG8_WAIT_L(0); PG8_MMA(1, 0, At, B0); PG8_BAR; PG8_SCHED;
            PG8_STAGE(PG8_SB(0, 1), b2 + hstepB, voffB);
            PG8_WAIT_V(6); PG8_BAR; PG8_MMA(1, 1, At, B1); PG8_BAR;
            PG8_LDB(B0, 1, 0); PG8_SCHED; PG8_LDA(At, 1, 0); PG8_STAGE(PG8_SA(0, 1), a2 + hstepA, voffA);
            PG8_WAIT_L(8); PG8_BAR; PG8_WAIT_L(0); PG8_MMA(0, 0, At, B0); PG8_BAR; PG8_SCHED;
            PG8_LDB(B1, 1, 1); PG8_STAGE(PG8_SB(1, 0), b3, voffB);
            PG8_BAR; PG8_WAIT_L(0); PG8_MMA(0, 1, At, B1); PG8_BAR;
            PG8_LDA(At, 1, 1); PG8_STAGE(PG8_SA(1, 0), a3, voffA);
            PG8_BAR; PG8_WAIT_L(0); PG8_MMA(1, 0, At, B0); PG8_BAR; PG8_SCHED;
            PG8_STAGE(PG8_SB(1, 1), b3 + hstepB, voffB);
            PG8_WAIT_V(6); PG8_BAR; PG8_MMA(1, 1, At, B1); PG8_BAR;
            }
        }
        if constexpr (ALIGN_EPI) { if (wr == 0) PG8_BAR; }
        if constexpr (!Epi::AFTER_DRAIN) { E(acc, cur, wr, wc, fr, fq); S.done(cur); }
        if (!has_next) break;
#pragma unroll
        for (int a = 0; a < 2; ++a)
#pragma unroll
            for (int b = 0; b < 2; ++b)
#pragma unroll
                for (int m = 0; m < 4; ++m)
#pragma unroll
                    for (int n = 0; n < 2; ++n) acc[a][b][m][n] = (f32x4){0.f, 0.f, 0.f, 0.f};
        cur = nxt; cA = nA; cB = nB; ++ui;
        if constexpr (ALIGN_EPI) { if (wr == 1) PG8_BAR; }
    }
    PG8_WAIT_V(0);
    if constexpr (!ALIGN_EPI) { if (wr == 0) PG8_BAR; }
    PG8_BAR;
    if constexpr (Epi::AFTER_DRAIN) { E.fused(acc, cur, wr, wc, fr, fq, lds, wid, lane); S.done(cur); }
#undef PG8_SA
#undef PG8_SB
#undef PG8_STAGE
#undef PG8_LDA
#undef PG8_LDB
#undef PG8_MMA
#undef PG8_WAIT_V
#undef PG8_WAIT_L
#undef PG8_BAR
#undef PG8_SCHED
}
}

namespace att2 {
typedef unsigned short bf16;
using bf16x8=__attribute__((ext_vector_type(8)))short;
using s16x4=__attribute__((ext_vector_type(4)))short;
using f32x16=__attribute__((ext_vector_type(16)))float;
using u32x4=__attribute__((ext_vector_type(4)))unsigned;
typedef _Float16 h16x8 __attribute__((ext_vector_type(8)));
constexpr int DQK=96,DV=64,OPITCH=512;
constexpr int NW=8,QBLK=32,QB=QBLK*NW,KVBLK=64;
__device__ __forceinline__ int crow(int r,int hi){return (r&3)+8*(r>>2)+4*hi;}
#define SBAR() __builtin_amdgcn_sched_barrier(0)
#define MFMA32(a,b,c) __builtin_amdgcn_mfma_f32_32x32x16_f16(__builtin_bit_cast(h16x8,a),__builtin_bit_cast(h16x8,b),c,0,0,0)
constexpr int NSLOT=3, KSLOT=12288, VSLOT=8192;
constexpr int LDS_K=0, LDS_V=NSLOT*KSLOT, LDS_WS=LDS_V+NSLOT*VSLOT, LDS_OST=LDS_WS+NW*64*4, LDS_BYTES=LDS_OST+NW*4096;
constexpr float QSCALE=0.10206207261596575f*1.4426950408889634f;
__device__ __forceinline__ void glds16(const void*gsrc,unsigned lds_dst){unsigned keep;
  asm volatile("s_mov_b32 %0, m0\n\ts_mov_b32 m0, %2\n\ts_nop 0\n\tglobal_load_lds_dwordx4 %1, off\n\ts_mov_b32 m0, %0":"=&s"(keep):"v"(gsrc),"s"(lds_dst):"memory");}
__device__ __forceinline__ float max3f(float a,float b,float c){float r;asm("v_max3_f32 %0, %1, %2, %3":"=v"(r):"v"(a),"v"(b),"v"(c));return r;}
__device__ __forceinline__ float max2f(float a,float b){float r;asm("v_max_f32_e32 %0, %1, %2":"=v"(r):"v"(a),"v"(b));return r;}
__device__ __forceinline__ float fadd_s(float a,float b){float r;asm("v_add_f32_e32 %0, %1, %2":"=v"(r):"v"(a),"v"(b));return r;}
__device__ __forceinline__ float fsub_s(float a,float b){float r;asm("v_sub_f32_e32 %0, %1, %2":"=v"(r):"v"(a),"v"(b));return r;}
typedef float f32x2_t __attribute__((ext_vector_type(2))); typedef _Float16 h16x2_t __attribute__((ext_vector_type(2)));
__device__ __forceinline__ unsigned cvtpk_s(float lo,float hi){f32x2_t v={lo,hi};h16x2_t b=__builtin_convertvector(v,h16x2_t);return __builtin_bit_cast(unsigned,b);}
#define WAIT_BAR(N) asm volatile("s_waitcnt vmcnt(" #N ") lgkmcnt(0)\n\ts_barrier":::"memory")

__device__ __forceinline__ void qkt(f32x16&p0,f32x16&p1,const char*Kslot,const bf16x8*qr,const f32x16&negm,int r32,int hi){
  const char*kb=Kslot+hi*1024+r32*16;
  #pragma unroll
  for(int d0=0;d0<6;++d0){
    const bf16x8 b0=*reinterpret_cast<const bf16x8*>(kb+d0*2048);
    const bf16x8 b1=*reinterpret_cast<const bf16x8*>(kb+d0*2048+512);
    if(d0==0){p0=MFMA32(b0,qr[0],negm);p1=MFMA32(b1,qr[0],negm);}
    else{p0=MFMA32(b0,qr[d0],p0);p1=MFMA32(b1,qr[d0],p1);}}
}
typedef __attribute__((address_space(3))) const char* lds_cptr;
typedef short v4i16_t __attribute__((ext_vector_type(4)));
__device__ __forceinline__ void kload2(bf16x8*kf,lds_cptr kp,int j){ kf[2*j]=*(const __attribute__((address_space(3))) bf16x8*)(kp+j*2048); kf[2*j+1]=*(const __attribute__((address_space(3))) bf16x8*)(kp+j*2048+512); }
__device__ __forceinline__ s16x4 vtr(lds_cptr p){ return __builtin_bit_cast(s16x4,__builtin_amdgcn_ds_read_tr16_b64_v4i16((__attribute__((address_space(3))) v4i16_t*)p)); }
__device__ __forceinline__ float rowmax(const f32x16&p0,const f32x16&p1){
  float a=max3f(p0[0],p0[1],p1[0]),b=max3f(p0[2],p0[3],p1[1]);a=max3f(a,p1[2],p1[3]);
  #pragma unroll
  for(int r=4;r<16;r+=4){a=max3f(a,p0[r],p0[r+1]);b=max3f(b,p0[r+2],p0[r+3]);a=max3f(a,p1[r],p1[r+1]);b=max3f(b,p1[r+2],p1[r+3]);}
  const float m=max2f(a,b);
  auto rr=__builtin_amdgcn_permlane32_swap(__float_as_uint(m),__float_as_uint(m),false,false);
  return max2f(__uint_as_float(rr[0]),__uint_as_float(rr[1]));
}
__device__ __forceinline__ void pv(f32x16*o,int vb,bf16x8 pa0,bf16x8 pa1,bf16x8 pa2,bf16x8 pa3){
  #pragma unroll
  for(int d0=0;d0<2;++d0){s16x4 lo[4],hi[4];
    #pragma unroll
    for(int ks=0;ks<4;++ks){
      asm volatile("ds_read_b64_tr_b16 %0,%1 offset:%c2":"=&v"(lo[ks]):"v"(vb),"i"(d0*4096+ks*1024):"memory");
      asm volatile("ds_read_b64_tr_b16 %0,%1 offset:%c2":"=&v"(hi[ks]):"v"(vb),"i"(d0*4096+ks*1024+512):"memory");}
    asm volatile("s_waitcnt lgkmcnt(0)":::"memory");SBAR();
    #define PK(k) (bf16x8){lo[k][0],lo[k][1],lo[k][2],lo[k][3],hi[k][0],hi[k][1],hi[k][2],hi[k][3]}
    o[d0]=MFMA32(pa0,PK(0),o[d0]);
    o[d0]=MFMA32(pa1,PK(1),o[d0]);
    o[d0]=MFMA32(pa2,PK(2),o[d0]);
    o[d0]=MFMA32(pa3,PK(3),o[d0]);
    #undef PK
  }
}

template<int THRL> __device__ __forceinline__ void attn_unit(const int wave_sgpr,const bf16*Qu,const bf16*__restrict__ Kh,const bf16*__restrict__ Vh,bf16*Ou,const int NT,char*shm){
  int lane_; asm volatile("v_mbcnt_lo_u32_b32 %0, -1, 0\n\tv_mbcnt_hi_u32_b32 %0, -1, %0" : "=v"(lane_));
  const int lane=lane_,r32=lane&31,hi=lane>>5; const int wid=wave_sgpr;
  const bf16*Qw=Qu+(long)(wid*QBLK)*DQK;
  const unsigned lds0=(unsigned)(uintptr_t)shm;
  float*wsf=(float*)(shm+LDS_WS)+wid*64;
  const int kcB=8+(wid&3);
  const bf16*ksrcA=Kh+(long)lane*DQK+wid*8;
  const bf16*ksrcB=Kh+(long)lane*DQK+kcB*8;
  const bf16*vsrc=Vh+(long)(16*(wid&3)+(lane>>2))*DV+(wid>>2)*32+(lane&3)*8;
  const unsigned kdstA=lds0+LDS_K+wid*1024, kdstB=lds0+LDS_K+kcB*1024, vdst=lds0+LDS_V+wid*1024;
  #define DMA_K(t,si) do{ glds16(ksrcA+(long)(t)*KVBLK*DQK,(unsigned)__builtin_amdgcn_readfirstlane(kdstA+(si)*KSLOT)); glds16(ksrcB+(long)(t)*KVBLK*DQK,(unsigned)__builtin_amdgcn_readfirstlane(kdstB+(si)*KSLOT)); }while(0)
  #define DMA_V(t,si) glds16(vsrc+(long)(t)*KVBLK*DV,(unsigned)__builtin_amdgcn_readfirstlane(vdst+(si)*VSLOT))
  const int vb0=(int)(lds0+LDS_V)+((lane>>4)&1)*32+(lane&3)*8+(4*hi+((lane&15)>>2))*64;
  const char*Kbase=shm+LDS_K; bf16x8 kf[12];
  const lds_cptr shm3=(lds_cptr)shm; const lds_cptr kp0=shm3+LDS_K+hi*1024+r32*16; const lds_cptr vp0=shm3+LDS_V+((lane>>4)&1)*32+(lane&3)*8+(4*hi+((lane&15)>>2))*64;
  DMA_K(0,0);DMA_V(0,0);DMA_K(1,1);
  bf16x8 qr[6];
  #pragma unroll
  for(int d0=0;d0<6;++d0)qr[d0]=*reinterpret_cast<const bf16x8*>(&Qw[(long)r32*DQK+d0*16+hi*8]);
  float mhat=0.f,l_reg=0.f;f32x16 o[2];o[0]=f32x16{};o[1]=f32x16{};f32x16 negm=f32x16{};asm volatile("":"+v"(negm));
  bool resc=false;
  #define START(P0,P1) do{ const float rm=rowmax(P0,P1); resc=false; \
    { const float dl=rm; mhat=fadd_s(mhat,dl); \
      _Pragma("unroll") for(int r=0;r<16;++r){P0[r]=fsub_s(P0[r],dl);P1[r]=fsub_s(P1[r],dl);} \
      _Pragma("unroll") for(int r=0;r<16;++r)negm[r]=-mhat; asm volatile("":"+v"(negm)); } \
    _Pragma("unroll") for(int r=0;r<16;++r)P0[r]=__builtin_amdgcn_exp2f(P0[r]); }while(0)
  #define RESC() do{ if(resc){ asm volatile("s_waitcnt lgkmcnt(0)":::"memory"); \
      _Pragma("unroll") for(int d_=0;d_<2;++d_) _Pragma("unroll") for(int r=0;r<16;++r)o[d_][r]*=wsf[crow(r,hi)]; } }while(0)
  f32x16 pA0,pA1,pB0,pB1;
  int sl_prev=0,sl_cur=0,sl_next=1;
  #define ROT() do{sl_prev=sl_cur;sl_cur=sl_next;sl_next=(sl_next==NSLOT-1)?0:sl_next+1;}while(0)
  DMA_K(2,2);
  WAIT_BAR(5);
  qkt(pA0,pA1,Kbase,qr,negm,r32,hi);asm volatile("s_nop 15\n\ts_nop 7":"+v"(pA0),"+v"(pA1));
  START(pA0,pA1);
  _Pragma("unroll") for(int r=0;r<16;++r)pA1[r]=__builtin_amdgcn_exp2f(pA1[r]);
  WAIT_BAR(0);
  DMA_K(3,0);DMA_V(1,1);
  ROT();
  #pragma unroll
  for(int j=0;j<6;++j)kload2(kf,kp0+sl_cur*KSLOT,j);
  WAIT_BAR(3);
  s16x4 vlo[8],vhi[8]; u32x4 pw0,pw1,pw2,pw3;
  #define PKW(P,B) cvtpk_s(P[B],P[B+1])
  #define PAF(k) __builtin_bit_cast(bf16x8,pw##k)
  #define VFR(i) (bf16x8){vlo[i][0],vlo[i][1],vlo[i][2],vlo[i][3],vhi[i][0],vhi[i][1],vhi[i][2],vhi[i][3]}
  #define PIN(x) asm volatile("":"+v"(x))
  #define MX3(a,b,c) __builtin_fmaxf(__builtin_fmaxf((a),(b)),(c))
  #define EX(v) __builtin_amdgcn_exp2f(v)
  #define GAPB(MF,X,B) do{ MF; X[B]=EX(X[B]); X[B+1]=EX(X[B+1]); X[B+2]=EX(X[B+2]); X[B+3]=EX(X[B+3]); PIN(X); SBAR(); }while(0)
  #define VRD(i) do{ vlo[i]=vtr(vp_+(((i)>>2)*4096+((i)&3)*1024)); vhi[i]=vtr(vp_+(((i)>>2)*4096+((i)&3)*1024+512)); }while(0)
  #define KRD(G,j) do{ if(G){ kload2(kf,kp0+sl_next*KSLOT,j); SBAR(); } }while(0)
  #define STEP(C0,C1,P0,P1,t,GK,GV,GL) do{ SBAR(); \
    const lds_cptr vp_=vp0+sl_prev*VSLOT; \
    VRD(0); SBAR(); float sacc=(P0[0]+P0[1]); \
    C0=MFMA32(kf[0],qr[0],negm); sacc+=P0[2]; sacc+=P0[3]; sacc+=P0[4]; PIN(sacc); pw0[0]=PKW(P0,0); pw0[1]=PKW(P0,2); PIN(pw0); SBAR(); \
    VRD(4); SBAR(); C1=MFMA32(kf[1],qr[0],negm); sacc+=P0[5]; sacc+=P0[6]; sacc+=P0[7]; PIN(sacc); pw0[2]=PKW(P0,4); PIN(pw0); SBAR(); \
    VRD(1); SBAR(); C0=MFMA32(kf[2],qr[1],C0); sacc+=P0[8]; sacc+=P0[9]; sacc+=P0[10]; PIN(sacc); pw0[3]=PKW(P0,6); pw1[0]=PKW(P0,8); PIN(pw0); PIN(pw1); SBAR(); \
    VRD(5); SBAR(); C1=MFMA32(kf[3],qr[1],C1); sacc+=P0[11]; sacc+=P0[12]; sacc+=P0[13]; PIN(sacc); pw1[1]=PKW(P0,10); PIN(pw1); SBAR(); \
    VRD(2); SBAR(); C0=MFMA32(kf[4],qr[2],C0); sacc+=P0[14]; sacc+=P0[15]; sacc+=P1[0]; PIN(sacc); pw1[2]=PKW(P0,12); pw1[3]=PKW(P0,14); PIN(pw1); SBAR(); \
    VRD(6); SBAR(); C1=MFMA32(kf[5],qr[2],C1); sacc+=P1[1]; sacc+=P1[2]; sacc+=P1[3]; PIN(sacc); pw2[0]=PKW(P1,0); PIN(pw2); SBAR(); \
    VRD(3); SBAR(); C0=MFMA32(kf[6],qr[3],C0); sacc+=P1[4]; sacc+=P1[5]; sacc+=P1[6]; PIN(sacc); pw2[1]=PKW(P1,2); pw2[2]=PKW(P1,4); PIN(pw2); SBAR(); \
    VRD(7); SBAR(); C1=MFMA32(kf[7],qr[3],C1); sacc+=P1[7]; sacc+=P1[8]; sacc+=P1[9]; PIN(sacc); pw2[3]=PKW(P1,6); PIN(pw2); SBAR(); \
    C0=MFMA32(kf[8],qr[4],C0); sacc+=P1[10]; sacc+=P1[11]; PIN(sacc); pw3[0]=PKW(P1,8); PIN(pw3); SBAR(); \
    C1=MFMA32(kf[9],qr[4],C1); sacc+=P1[12]; sacc+=P1[13]; PIN(sacc); pw3[1]=PKW(P1,10); PIN(pw3); SBAR(); \
    C0=MFMA32(kf[10],qr[5],C0); sacc+=P1[14]; PIN(sacc); pw3[2]=PKW(P1,12); PIN(pw3); SBAR(); \
    C1=MFMA32(kf[11],qr[5],C1); sacc+=P1[15]; PIN(sacc); pw3[3]=PKW(P1,14); PIN(pw3); SBAR(); \
    l_reg+=sacc; \
    if(GK){DMA_K((t)+3,sl_cur);} if(GV){DMA_V((t)+1,sl_next);} \
    { float a=MX3(C0[0],C0[1],C1[0]),b=MX3(C0[2],C0[3],C1[1]); a=MX3(a,C1[2],C1[3]); \
      _Pragma("unroll") for(int r=4;r<16;r+=4){a=MX3(a,C0[r],C0[r+1]);b=MX3(b,C0[r+2],C0[r+3]);a=MX3(a,C1[r],C1[r+1]);b=MX3(b,C1[r+2],C1[r+3]);} \
      float rm=__builtin_fmaxf(a,b); { auto rr=__builtin_amdgcn_permlane32_swap(__float_as_uint(rm),__float_as_uint(rm),false,false); rm=__builtin_fmaxf(__uint_as_float(rr[0]),__uint_as_float(rr[1])); } \
      resc=false; \
      if(__builtin_expect(__any(rm>(float)THRL),0)){ const float dl=__builtin_fmaxf(rm,0.f); mhat+=dl; \
        _Pragma("unroll") for(int r=0;r<16;++r){C0[r]-=dl;C1[r]-=dl;} \
        _Pragma("unroll") for(int r=0;r<16;++r)negm[r]=-mhat; asm volatile("":"+v"(negm)); \
        const float f=__builtin_amdgcn_exp2f(-dl); l_reg*=f; if(hi==0)wsf[r32]=f; resc=true; } } \
    SBAR(); \
    GAPB(o[0]=MFMA32(PAF(0),VFR(0),o[0]), C0,0); \
    KRD(GL,0); GAPB(o[1]=MFMA32(PAF(0),VFR(4),o[1]), C0,4); \
    KRD(GL,1); GAPB(o[0]=MFMA32(PAF(1),VFR(1),o[0]), C0,8); \
    KRD(GL,2); GAPB(o[1]=MFMA32(PAF(1),VFR(5),o[1]), C0,12); \
    KRD(GL,3); GAPB(o[0]=MFMA32(PAF(2),VFR(2),o[0]), C1,0); \
    KRD(GL,4); GAPB(o[1]=MFMA32(PAF(2),VFR(6),o[1]), C1,4); \
    KRD(GL,5); GAPB(o[0]=MFMA32(PAF(3),VFR(3),o[0]), C1,8); \
    GAPB(o[1]=MFMA32(PAF(3),VFR(7),o[1]), C1,12); \
    }while(0)
  int t=1;
  for(;t+5<NT;t+=2){
    STEP(pB0,pB1,pA0,pA1,t,true,true,true);     WAIT_BAR(3); RESC(); ROT();
    STEP(pA0,pA1,pB0,pB1,t+1,true,true,true);   WAIT_BAR(3); RESC(); ROT();
  }
  #define ENDW(tt) do{ if((tt)+3<NT){WAIT_BAR(3);} else if((tt)+2<NT){WAIT_BAR(1);} else {WAIT_BAR(0);} }while(0)
  for(;t+1<NT;t+=2){
    STEP(pB0,pB1,pA0,pA1,t,(t+3<NT),(t+1<NT),(t+1<NT));       ENDW(t);   RESC(); ROT();
    STEP(pA0,pA1,pB0,pB1,t+1,(t+4<NT),(t+2<NT),(t+2<NT));     ENDW(t+1); RESC(); ROT();
  }
  STEP(pB0,pB1,pA0,pA1,NT-1,false,false,false); RESC();
  { float sacc=pB0[0]+pB0[1]; _Pragma("unroll") for(int r=2;r<16;++r)sacc+=pB0[r]; _Pragma("unroll") for(int r=0;r<16;++r)sacc+=pB1[r]; l_reg+=sacc;
    pw0=(u32x4){PKW(pB0,0),PKW(pB0,2),PKW(pB0,4),PKW(pB0,6)};pw1=(u32x4){PKW(pB0,8),PKW(pB0,10),PKW(pB0,12),PKW(pB0,14)};pw2=(u32x4){PKW(pB1,0),PKW(pB1,2),PKW(pB1,4),PKW(pB1,6)};pw3=(u32x4){PKW(pB1,8),PKW(pB1,10),PKW(pB1,12),PKW(pB1,14)};
    SBAR(); pv(o,vb0+sl_cur*VSLOT,PAF(0),PAF(1),PAF(2),PAF(3)); }
  #undef PKW
  #undef PAF
  #undef VFR
  #undef PIN
  #undef MX3
  #undef GAPB
  #undef EX
  #undef VRD
  #undef KRD
  #undef STEP
  #undef ENDW
  {auto rr=__builtin_amdgcn_permlane32_swap(__float_as_uint(l_reg),__float_as_uint(l_reg),false,false);l_reg=__uint_as_float(rr[0])+__uint_as_float(rr[1]);}
  if(hi==0)wsf[32+r32]=l_reg;asm volatile("s_waitcnt lgkmcnt(0)":::"memory");
  float rli[16];
  #pragma unroll
  for(int r=0;r<16;++r)rli[r]=__builtin_amdgcn_rcpf(wsf[32+crow(r,hi)]);
  bf16*Ow=Ou+(long)(wid*QBLK)*OPITCH;
  { bf16*stg=(bf16*)(shm+LDS_OST)+wid*2048;
    #pragma unroll
    for(int r=0;r<16;++r){const int orow=crow(r,hi);
      #pragma unroll
      for(int d0=0;d0<2;++d0)stg[orow*64+d0*32+r32]=(bf16)(cvtpk_s(o[d0][r]*rli[r],0.f)&0xffffu);}
    asm volatile("s_waitcnt lgkmcnt(0)":::"memory");
    #pragma unroll
    for(int i=0;i<4;++i){const int row=i*8+(lane>>3),ch=lane&7; const u32x4 v=*(const u32x4*)(stg+row*64+ch*8); *(u32x4*)(Ow+(long)row*OPITCH+ch*8)=v;} }
  asm volatile("s_waitcnt lgkmcnt(0)\n\ts_barrier":::"memory");
  #undef DMA_K
  #undef DMA_V
  #undef START
  #undef RESC
  #undef ROT
}
#undef SBAR
#undef WAIT_BAR
#undef MFMA32
}


constexpr int NWAVES = 8;
constexpr int DM = 1024, NL = 4, TG = 16384  , NGRP = 2, NB = 10  ;
constexpr int NH = 8, DQK = 96, DV = 64, QLORA = 384, KVLORA = 256, DROPE = 32, NIN = 4768, NINP = 4864, DFF = 2816, NMOD = 6 * DM;
constexpr int LATW = 768;
constexpr float EPS = 1e-6f;
constexpr int KSPLIT = 8;
#ifndef MK_ONE_LAUNCH
#define MK_ONE_LAUNCH 1
#endif

constexpr size_t MiB = 1u << 20;
constexpr int TG2 = NGRP * TG;
constexpr size_t WS_CTL = 0, CTL_ZERO_BYTES = 1 * MiB;
constexpr size_t WS_MOD = 1 * MiB;
constexpr size_t WS_ROPE = 2 * MiB;
constexpr size_t WS_AV = 3 * MiB;
constexpr size_t WS_MODP = 4 * MiB;
constexpr size_t WS_SSL = 4 * MiB, WS_SSG = 5 * MiB;
constexpr size_t WS_SHA = 12 * MiB;
constexpr size_t WS_BIAS = 16 * MiB;
constexpr size_t WS_SSX = 18 * MiB;
constexpr size_t WS_WB = 20 * MiB, WB_LAYER = 65 * 512 * 1024;
constexpr size_t WO_IN = 0, WO_FI = WO_IN + (size_t)NINP * DM, WO_QB = WO_FI + (size_t)2 * DFF * DM, WO_KVB = WO_QB + (size_t)1024 * QLORA, WO_OA = WO_KVB + (size_t)1024 * KVLORA, WO_S = WO_OA + (size_t)DM * 512,
                 WO_OB = WO_S + (size_t)8 * 128 * 128, WO_OUT = WO_OB + (size_t)DM * DM, WO_FO = WO_OUT + (size_t)DM * DM, WO_END = WO_FO + (size_t)DM * DFF;
static_assert(WO_END * 2 <= WB_LAYER && WO_FI == (size_t)19 * 256 * 1024, "layer weight block");
constexpr size_t WS_HH = 150 * MiB;
constexpr size_t WS_X16 = 214 * MiB;
constexpr size_t WS_U = 278 * MiB, WS_GV = 310 * MiB, WS_SGA = 342 * MiB, WS_SGB = 374 * MiB;
constexpr size_t WS_TMP = 406 * MiB;
constexpr size_t WS_ACT = WS_U, WS_END = 454 * MiB;
static_assert(WS_ACT + (size_t)TG2 * DFF * 2 <= WS_END && WS_WB + NL * WB_LAYER <= WS_HH, "d_ws map");
constexpr size_t DO_Q = 0, DO_K = 24 * MiB, DO_V = 48 * MiB, DO_O = 64 * MiB, DO_LAT = 80 * MiB;
static_assert(DO_LAT + (size_t)TG * LATW * 2 <= (size_t)TG2 * DM * 4, "d_out scratch map");
constexpr int CW_BAR = 4096;

constexpr int RING_BYTES = 131072;
constexpr int LDSCTL_OFF = RING_BYTES, MISC_OFF = LDSCTL_OFF + 320;
constexpr int LDS_BYTES = 147456;
constexpr int RTAB_OFF = 132096;

#define GAS __attribute__((address_space(1)))
#define LAS __attribute__((address_space(3)))
typedef unsigned short bf16;
typedef unsigned v4u __attribute__((ext_vector_type(4)));
typedef unsigned v2u __attribute__((ext_vector_type(2)));
typedef float f32x4 __attribute__((ext_vector_type(4)));
typedef short bf16x8 __attribute__((ext_vector_type(8)));
#define LDS_WAIT() asm volatile("s_waitcnt lgkmcnt(0)" ::: "memory")
typedef _Float16 h16x2 __attribute__((ext_vector_type(2)));
typedef _Float16 h16x8 __attribute__((ext_vector_type(8)));
typedef float f32x2 __attribute__((ext_vector_type(2)));
__device__ __forceinline__ unsigned f2bf(float f) { return (unsigned)__builtin_bit_cast(unsigned short, (_Float16)f); }
__device__ __forceinline__ unsigned pk2(float lo, float hi) { const f32x2 v = {lo, hi}; return __builtin_bit_cast(unsigned, __builtin_convertvector(v, h16x2)); }
__device__ __forceinline__ float bflo(unsigned w) { return (float)__builtin_bit_cast(h16x2, w)[0]; }
__device__ __forceinline__ float bfhi(unsigned w) { return (float)__builtin_bit_cast(h16x2, w)[1]; }
__device__ __forceinline__ float wave_sum(float v) {
    v += __int_as_float(__builtin_amdgcn_ds_swizzle(__float_as_int(v), 0x041F));
    v += __int_as_float(__builtin_amdgcn_ds_swizzle(__float_as_int(v), 0x081F));
    v += __int_as_float(__builtin_amdgcn_ds_swizzle(__float_as_int(v), 0x101F));
    v += __int_as_float(__builtin_amdgcn_ds_swizzle(__float_as_int(v), 0x201F));
    v += __int_as_float(__builtin_amdgcn_ds_swizzle(__float_as_int(v), 0x401F));
    auto rr = __builtin_amdgcn_permlane32_swap(__float_as_uint(v), __float_as_uint(v), false, false);
    return __uint_as_float(rr[0]) + __uint_as_float(rr[1]);
}

__device__ __forceinline__ int lane_id_now() { int l; asm volatile("v_mbcnt_lo_u32_b32 %0, -1, 0\n\tv_mbcnt_hi_u32_b32 %0, -1, %0" : "=v"(l)); return l; }

#define XB_TMO      128
#define XB_XCNT(j)  (256  + 64 * (j))
#define XB_XSUB(j)  (1280 + 64 * (j))
#define XB_XGEN(j)  (2304 + 64 * (j))
#define XB_TOP      3328
#define XB_TOPGEN   3392
#define XCD_BAR_WORDS 3456
#define XB_SPIN_CAP (1u << 18)

__device__ __forceinline__ unsigned xb_ld(unsigned* p)              { return __hip_atomic_load(p, __ATOMIC_RELAXED, __HIP_MEMORY_SCOPE_AGENT); }
__device__ __forceinline__ unsigned xb_add(unsigned* p, unsigned v) { return __hip_atomic_fetch_add(p, v, __ATOMIC_RELAXED, __HIP_MEMORY_SCOPE_AGENT); }
__device__ __forceinline__ unsigned xb_xcc_id() { return (unsigned)__builtin_amdgcn_s_getreg((3 << 11) | 20) & 0xFu; }
#define XB_SPIN(cond, bar) do { unsigned _sp = 0; while (cond) { __builtin_amdgcn_s_sleep(1); \
    if ((++_sp & 255u) == 0u) { if (xb_ld(&(bar)[XB_TMO])) break; if (_sp > XB_SPIN_CAP) { atomicAdd(&(bar)[XB_TMO], 1u); break; } } } } while (0)

struct XcdBarrier {
    unsigned* bar; unsigned x;
    volatile LAS unsigned* st;
};

__device__ __forceinline__ XcdBarrier xcd_barrier_post(unsigned* bar, volatile LAS unsigned* st) {
    XcdBarrier b; b.bar = bar; b.x = xb_xcc_id(); b.st = st;
    if (threadIdx.x == 0) (void)xb_add(&bar[XB_XCNT(b.x)], 1u);
    return b;
}
__device__ __forceinline__ void xcd_barrier_complete(unsigned* bar, unsigned x, unsigned& nloc, unsigned& nx) {
    const unsigned G = gridDim.x * gridDim.y * gridDim.z;
    unsigned sum, cnt, mine, sp = 0u;
    for (;;) {
        sum = 0u; cnt = 0u; mine = 0u;
#pragma unroll
        for (unsigned j = 0; j < 16; ++j) { const unsigned c = xb_ld(&bar[XB_XCNT(j)]); sum += c; cnt += (c > 0u) ? 1u : 0u; mine = (j == x) ? c : mine; }
        if (sum == G) break;
        __builtin_amdgcn_s_sleep(1);
        if ((++sp & 255u) == 0u) { if (xb_ld(&bar[XB_TMO])) break; if (sp > XB_SPIN_CAP) { atomicAdd(&bar[XB_TMO], 1u); break; } }
    }
    nloc = mine > 0u ? mine : 1u; nx = cnt > 0u ? cnt : 1u;
}

__device__ __forceinline__ void xcd_barrier(const XcdBarrier& b) {
    asm volatile("s_waitcnt vmcnt(0)" ::: "memory");
    __syncthreads();
    if (threadIdx.x == 0) {
        unsigned* bar = b.bar;
        __builtin_amdgcn_s_waitcnt(0);
        unsigned nloc = b.st[0], nx = b.st[1];
        if (nloc == 0u) { xcd_barrier_complete(bar, b.x, nloc, nx); b.st[0] = nloc; b.st[1] = nx; }
        const unsigned old = xb_add(&bar[XB_XSUB(b.x)], 1u);
        const unsigned gen = old / nloc;
        if (old + 1u == (gen + 1u) * nloc) {
            __builtin_amdgcn_fence(__ATOMIC_RELEASE, "agent");
            asm volatile("s_waitcnt vmcnt(0)" ::: "memory");
            const unsigned og = xb_add(&bar[XB_TOP], 1u);
            const unsigned tg = og / nx;
            if (og + 1u == (tg + 1u) * nx) xb_add(&bar[XB_TOPGEN], 1u);
            else XB_SPIN(xb_ld(&bar[XB_TOPGEN]) == tg, bar);
            __builtin_amdgcn_fence(__ATOMIC_ACQUIRE, "agent");
            xb_add(&bar[XB_XGEN(b.x)], 1u);
            asm volatile("s_waitcnt vmcnt(0)" ::: "memory");
        } else {
            XB_SPIN(xb_ld(&bar[XB_XGEN(b.x)]) == gen, bar);
            __builtin_amdgcn_fence(__ATOMIC_ACQUIRE, "agent");
            asm volatile("s_waitcnt vmcnt(0)" ::: "memory");
        }
    }
    __syncthreads();
}

struct Frame {
    LAS unsigned char* lds;
    int tid, lane, wave, vcu, G;
    const float* in[23]; float* out; unsigned char* ws;
};
__constant__ double ROPE_INV[16] = {1.0, 0.5623413251903491, 0.31622776601683794, 0.1778279410038923, 0.1, 0.05623413251903491, 0.03162277660168379, 0.01778279410038923,
                                    0.01, 0.005623413251903491, 0.0031622776601683794, 0.0017782794100389228, 0.001, 0.0005623413251903491, 0.00031622776601683794, 0.00017782794100389227};

__device__ __forceinline__ void transpose_item(const float* W, int K, int N, bf16* WT, int k0, int n0, int drow0, const float* kscale, LAS float* scr, int lane) {
#pragma unroll 8
    for (int i = 0; i < 32; ++i) { const int kk = 2 * i + (lane >> 5); float v = W[(size_t)(k0 + kk) * N + n0 + (lane & 31)]; if (kscale) v *= kscale[k0 + kk]; scr[kk * 33 + (lane & 31)] = v; }
    LDS_WAIT(); asm volatile("" ::: "memory");
    const int c = lane & 7;
#pragma unroll
    for (int j = 0; j < 4; ++j) { const int n = (lane >> 3) + 8 * j; const LAS float* s = scr + (8 * c) * 33 + n;
        v4u o; o.x = pk2(s[0 * 33], s[1 * 33]); o.y = pk2(s[2 * 33], s[3 * 33]); o.z = pk2(s[4 * 33], s[5 * 33]); o.w = pk2(s[6 * 33], s[7 * 33]);
        *(GAS v4u*)(WT + (size_t)(drow0 + n) * K + k0 + 8 * c) = o; }
    LDS_WAIT(); asm volatile("" ::: "memory");
}
__device__ __forceinline__ int win_row(int n0) { return n0 < 384 ? n0 : (n0 < 640 ? 512 + (n0 - 384) : (n0 < 672 ? 384 + (n0 - 640) : 768 + (n0 - 672))); }
__device__ __forceinline__ int wfi_row(int n0) { const int g = n0 >= DFF ? 1 : 0, n = n0 - g * DFF; return (n >> 7) * 256 + g * 128 + (n & 127); }

__device__ __forceinline__ void pre0(Frame& F) {
    LAS float* scr = (LAS float*)(F.lds + F.wave * 16384);
    const int gw = F.vcu * NWAVES + F.wave, NGW = F.G * NWAVES;
    constexpr int I_IN = (DM / 64) * (NIN / 32), I_QB = (QLORA / 64) * (768 / 32), I_KVB = (KVLORA / 64) * (1024 / 32), I_OA = (512 / 64) * (DM / 32), I_OB = (DM / 64) * (DM / 32), I_OUT = I_OB,
                  I_FI = (DM / 64) * (2 * DFF / 32), I_FO = (DFF / 64) * (DM / 32), I_L = I_IN + I_QB + I_KVB + I_OA + I_OB + I_OUT + I_FI + I_FO;
    for (int it = gw; it < NL * I_L; it += NGW) {
        const int l = it / I_L; int r = it % I_L;
        bf16* wb = (bf16*)(F.ws + WS_WB + (size_t)l * WB_LAYER);
        if (r < I_IN) { const int nb = NIN / 32, kb = r / nb, n0 = (r % nb) * 32; transpose_item(F.in[7] + (size_t)l * DM * NIN, DM, NIN, wb + WO_IN, kb * 64, n0, win_row(n0), nullptr, scr, F.lane); continue; } r -= I_IN;
        if (r < I_QB) { const int nb = 768 / 32, kb = r / nb, n0 = (r % nb) * 32; transpose_item(F.in[10] + (size_t)l * QLORA * 768, QLORA, 768, wb + WO_QB, kb * 64, n0, (n0 / 96) * 128 + n0 % 96, F.in[8] + l * QLORA, scr, F.lane); continue; } r -= I_QB;
        if (r < I_KVB) { const int nb = 1024 / 32, kb = r / nb, n0 = (r % nb) * 32; transpose_item(F.in[11] + (size_t)l * KVLORA * 1024, KVLORA, 1024, wb + WO_KVB, kb * 64, n0, n0, F.in[9] + l * KVLORA, scr, F.lane); continue; } r -= I_KVB;
        if (r < I_OA) { const int nb = DM / 32, kb = r / nb, n0 = (r % nb) * 32; transpose_item(F.in[14] + (size_t)l * 512 * DM, 512, DM, wb + WO_OA, kb * 64, n0, n0, nullptr, scr, F.lane); continue; } r -= I_OA;
        if (r < I_OB) { const int nb = DM / 32, kb = r / nb, n0 = (r % nb) * 32; transpose_item(F.in[18] + (size_t)l * DM * DM, DM, DM, wb + WO_OB, kb * 64, n0, n0, nullptr, scr, F.lane); continue; } r -= I_OB;
        if (r < I_OUT) { const int nb = DM / 32, kb = r / nb, n0 = (r % nb) * 32; transpose_item(F.in[19] + (size_t)l * DM * DM, DM, DM, wb + WO_OUT, kb * 64, n0, n0, nullptr, scr, F.lane); continue; } r -= I_OUT;
        if (r < I_FI) { const int nb = 2 * DFF / 32, kb = r / nb, n0 = (r % nb) * 32; transpose_item(F.in[21] + (size_t)l * DM * 2 * DFF, DM, 2 * DFF, wb + WO_FI, kb * 64, n0, wfi_row(n0), nullptr, scr, F.lane); continue; } r -= I_FI;
        { const int nb = DM / 32, kb = r / nb, n0 = (r % nb) * 32; transpose_item(F.in[22] + (size_t)l * DFF * DM, DFF, DM, wb + WO_FO, kb * 64, n0, n0, nullptr, scr, F.lane); }
    }
    {
        const int gt = F.vcu * (NWAVES * 64) + F.tid, NT = F.G * NWAVES * 64;
        for (int i = gt; i < NL * 96 * (DM / 8); i += NT) { const int l = i / (96 * (DM / 8)), r = i % (96 * (DM / 8));
            *(GAS v4u*)((bf16*)(F.ws + WS_WB + (size_t)l * WB_LAYER) + WO_IN + (size_t)(416 + r / (DM / 8)) * DM + (r % (DM / 8)) * 8) = (v4u){0u, 0u, 0u, 0u}; }
        for (int i = gt; i < NL * 8 * 32 * (QLORA / 8); i += NT) { const int l = i / (8 * 32 * (QLORA / 8)), r = i % (8 * 32 * (QLORA / 8)), rw = r / (QLORA / 8);
            *(GAS v4u*)((bf16*)(F.ws + WS_WB + (size_t)l * WB_LAYER) + WO_QB + (size_t)((rw >> 5) * 128 + 96 + (rw & 31)) * QLORA + (r % (QLORA / 8)) * 8) = (v4u){0u, 0u, 0u, 0u}; }
        for (int i = gt; i < NL * 8 * 128 * 128 / 4; i += NT) { const int l = i / (8 * 128 * 128 / 4), r = i % (8 * 128 * 128 / 4);
            const f32x4 v = *(const f32x4*)(F.in[16] + (size_t)l * 131072 + (size_t)r * 4);
            *(GAS v2u*)((bf16*)(F.ws + WS_WB + (size_t)l * WB_LAYER) + WO_S + (size_t)r * 4) = (v2u){pk2(v.x, v.y), pk2(v.z, v.w)}; }
        float* rc = (float*)(F.ws + WS_ROPE); float* rs = rc + 8192 * 16;
        for (int i = gt; i < 8192 * 16; i += NT) { const int pos = i >> 4, k = i & 15;
            double t = (double)pos * ROPE_INV[k] * 0.15915494309189535; t -= __builtin_rint(t);
            const float tf = (float)t; rc[i] = __builtin_amdgcn_cosf(tf); rs[i] = __builtin_amdgcn_sinf(tf); }
    }
    {
        LAS float* sv = (LAS float*)F.lds;
        constexpr int NCB = NMOD / 512, NITEM = NL * KSPLIT * NCB;
        for (int it = F.vcu; it < NITEM; it += F.G) {
            const int l = it / (KSPLIT * NCB), kc = (it / NCB) % KSPLIT, cb = it % NCB;
            __syncthreads();
            for (int i = F.tid; i < NB * 128; i += NWAVES * 64) { const int b = i >> 7, k = kc * 128 + (i & 127);
                const float c = b < 2 ? F.in[2][b * DM + k] : F.in[3][(b - 2) * DM + k]; sv[i] = c * __builtin_amdgcn_rcpf(1.0f + __expf(-c)); }
            __syncthreads();
            const int n = cb * 512 + F.tid; const float* w = F.in[4] + ((size_t)l * DM + kc * 128) * NMOD + n;
            float a[NB];
#pragma unroll
            for (int b = 0; b < NB; ++b) a[b] = 0.f;
#pragma unroll 8
            for (int k = 0; k < 128; ++k) { const float wv = w[(size_t)k * NMOD];
#pragma unroll
                for (int b = 0; b < NB; ++b) a[b] = fmaf(sv[b * 128 + k], wv, a[b]); }
            float* mp = (float*)(F.ws + WS_MODP) + ((size_t)(kc * NL + l) * NB) * NMOD + n;
#pragma unroll
            for (int b = 0; b < NB; ++b) mp[(size_t)b * NMOD] = a[b];
        }
        __syncthreads();
    }
}
__device__ __forceinline__ void pre1(Frame& F) {
    const int gt = F.vcu * (NWAVES * 64) + F.tid, NT = F.G * NWAVES * 64;
    const float* mp = (const float*)(F.ws + WS_MODP); float* mod = (float*)(F.ws + WS_MOD);
    float* av = (float*)(F.ws + WS_AV); bf16* sha = (bf16*)(F.ws + WS_SHA);
    for (int i = gt; i < NL * NB * NMOD; i += NT) { const int l = i / (NB * NMOD), b = (i / NMOD) % NB, n = i % NMOD, chunk = n >> 10, c = n & 1023;
        float s = F.in[5][l * NMOD + n];
#pragma unroll
        for (int kc = 0; kc < KSPLIT; ++kc) s += mp[(size_t)kc * NL * NB * NMOD + i];
        mod[i] = s;
        if (chunk == 1) av[((size_t)l * NB + b) * DM + c] = F.in[6][l * DM + c] * (1.0f + s);
        else if (chunk == 4) av[(size_t)NL * NB * DM + ((size_t)l * NB + b) * DM + c] = F.in[20][l * DM + c] * (1.0f + s);
        else if (chunk == 0) sha[((size_t)(l * 2 + 0) * 256 + b) * DM + c] = (bf16)f2bf(s);
        else if (chunk == 3) sha[((size_t)(l * 2 + 1) * 256 + b) * DM + c] = (bf16)f2bf(s); }
    for (int i = gt; i < NL * 2 * 246 * (DM / 8); i += NT) { const int t = i / (246 * (DM / 8)), r = i % (246 * (DM / 8));
        *(GAS v4u*)(sha + ((size_t)t * 256 + 10 + r / (DM / 8)) * DM + (r % (DM / 8)) * 8) = (v4u){0u, 0u, 0u, 0u}; }
}
__device__ __forceinline__ void h0_init(Frame& F) {
    const int gw = F.vcu * NWAVES + F.wave, NGW = F.G * NWAVES;
    const float* av = (const float*)(F.ws + WS_AV); bf16* HH = (bf16*)(F.ws + WS_HH); float* ssx = (float*)(F.ws + WS_SSX);
#pragma nounroll
    for (int r = gw; r < TG2; r += NGW) {
        const float* xrow = r < TG ? F.in[0] + (size_t)r * DM : F.in[1] + (size_t)(r - TG) * DM;
        const float* a = av + (size_t)pg8::seq_of_row(r) * DM;
        const GAS f32x4* xr = (const GAS f32x4*)xrow + F.lane;
        GAS v2u* o8 = (GAS v2u*)(HH + (size_t)r * DM) + F.lane; float s = 0.f;
#pragma unroll
        for (int j = 0; j < 4; ++j) { const f32x4 v = xr[64 * j]; const f32x4 aa = *(const f32x4*)(a + 4 * F.lane + 256 * j); const f32x4 y = v * aa;
            s += (v.x * v.x + v.y * v.y) + (v.z * v.z + v.w * v.w); o8[64 * j] = (v2u){pk2(y.x, y.y), pk2(y.z, y.w)}; }
        s = wave_sum(s);
        if (F.lane < 16) ssx[(size_t)r * 16 + F.lane] = F.lane == 0 ? s : 0.f;
    }
}
struct SguLoads { v4u gv[4]; f32x4 ss[4]; bf16x8 wf[4]; v2u uu[8]; f32x4 sg[2][2]; float bias; };
__device__ __forceinline__ void sgu_mix(Frame& F, const bf16* GV, const float* SSG, const float* sg, const bf16* Ws  , const float* bs  , bf16* U) {
    constexpr int VP = 136;
    LAS bf16* vT = (LAS bf16*)F.lds; LAS float* rq = (LAS float*)(F.lds + 128 * VP * 2);
    const int lane = F.lane, w = F.wave, tid = F.tid;
    const int NU = (TG / 128) * 8;
#define SGU_LOAD(L, it) do { const int ck_ = (it) >> 3, gi_ = (it) & 7; \
        _Pragma("unroll") for (int i = 0; i < 4; ++i) { const int q = lane + 64 * (i & 1), c8 = 8 * (w + 8 * (i >> 1)); L.gv[i] = *(const v4u*)(GV + (size_t)(ck_ * 128 + q) * DM + gi_ * 128 + c8); } \
        if (tid < 128) { _Pragma("unroll") for (int j = 0; j < 4; ++j) L.ss[j] = *(const f32x4*)(SSG + (size_t)(ck_ * 128 + tid) * 16 + 4 * j); } \
        { const int p_ = 16 * w + (lane & 15); \
          _Pragma("unroll") for (int ks = 0; ks < 4; ++ks) L.wf[ks] = *(const bf16x8*)(Ws + ((size_t)gi_ * 128 + p_) * 128 + 32 * ks + 8 * (lane >> 4)); \
          _Pragma("unroll") for (int cb = 0; cb < 8; ++cb) L.uu[cb] = *(const v2u*)(U + ((size_t)ck_ * 128 + p_) * DM + gi_ * 128 + 16 * cb + 4 * (lane >> 4)); \
          L.bias = bs[gi_ * 128 + p_]; } \
        _Pragma("unroll") for (int hf = 0; hf < 2; ++hf) { const int c8 = 8 * (w + 8 * hf); L.sg[hf][0] = *(const f32x4*)(sg + gi_ * 128 + c8); L.sg[hf][1] = *(const f32x4*)(sg + gi_ * 128 + c8 + 4); } } while (0)
#define SGU_RUN(L, it, LN, itn) do { const int ck_ = (it) >> 3, gi_ = (it) & 7; \
        __syncthreads(); \
        if (tid < 128) { const f32x4 a_ = L.ss[0], b_ = L.ss[1], c_ = L.ss[2], d_ = L.ss[3]; \
            const float s_ = ((a_[0] + a_[1]) + (a_[2] + a_[3])) + ((b_[0] + b_[1]) + (b_[2] + b_[3])) + ((c_[0] + c_[1]) + (c_[2] + c_[3])) + ((d_[0] + d_[1]) + (d_[2] + d_[3])); \
            rq[tid] = 1.0f / sqrtf(s_ * (1.0f / 1024.0f) + EPS); } \
        __syncthreads(); \
        { _Pragma("unroll") for (int i = 0; i < 4; ++i) { const int q = lane + 64 * (i & 1), c8 = 8 * (w + 8 * (i >> 1)); const v4u wv = L.gv[i]; const f32x4 g0 = L.sg[i >> 1][0], g1 = L.sg[i >> 1][1]; \
            const float gq[8] = {g0[0], g0[1], g0[2], g0[3], g1[0], g1[1], g1[2], g1[3]}; \
            const float x[8] = {bflo(wv.x), bfhi(wv.x), bflo(wv.y), bfhi(wv.y), bflo(wv.z), bfhi(wv.z), bflo(wv.w), bfhi(wv.w)}; const float r = rq[q]; \
            _Pragma("unroll") for (int j = 0; j < 8; ++j) vT[(c8 + j) * VP + q] = (bf16)f2bf(x[j] * r * gq[j]); } } \
        __syncthreads(); \
        if ((itn) < NU) SGU_LOAD(LN, itn);                           \
        f32x4 acc[8]; \
        _Pragma("unroll") for (int cb = 0; cb < 8; ++cb) acc[cb] = (f32x4){0.f, 0.f, 0.f, 0.f}; \
        _Pragma("unroll") for (int ks = 0; ks < 4; ++ks) { \
            _Pragma("unroll") for (int cb = 0; cb < 8; ++cb) { const bf16x8 afrag = *(const LAS bf16x8*)(vT + (16 * cb + (lane & 15)) * VP + 32 * ks + 8 * (lane >> 4)); \
                acc[cb] = __builtin_amdgcn_mfma_f32_16x16x32_f16(__builtin_bit_cast(h16x8, afrag), __builtin_bit_cast(h16x8, L.wf[ks]), acc[cb], 0, 0, 0); } } \
        { const int p_ = 16 * w + (lane & 15); const float bias = L.bias; \
          _Pragma("unroll") for (int cb = 0; cb < 8; ++cb) { bf16* up = U + ((size_t)ck_ * 128 + p_) * DM + gi_ * 128 + 16 * cb + 4 * (lane >> 4); const v2u uw = L.uu[cb]; \
            *(GAS v2u*)up = (v2u){pk2(bflo(uw.x) * (acc[cb][0] + bias), bfhi(uw.x) * (acc[cb][1] + bias)), pk2(bflo(uw.y) * (acc[cb][2] + bias), bfhi(uw.y) * (acc[cb][3] + bias))}; } } } while (0)
    SguLoads A, B;
    int it = F.vcu;
    if (it < NU) SGU_LOAD(A, it);
#pragma nounroll
    for (; it < NU; it += 2 * F.G) {
        SGU_RUN(A, it, B, it + F.G);
        if (it + F.G < NU) SGU_RUN(B, it + F.G, A, it + 2 * F.G);
    }
#undef SGU_LOAD
#undef SGU_RUN
    __syncthreads();
}
__device__ __forceinline__ void attn_phase(Frame& F, const bf16* Q, const bf16* K, const bf16* V, bf16* O, int nbatch, int seqlen) {
    const int nqb = seqlen / 256, nunits = nbatch * NH * nqb;
    for (int u = F.vcu; u < nunits; u += F.G) {
        const int bh = u / nqb, qb = u % nqb, b = bh / NH, h = bh % NH;
        att2::attn_unit<8>(F.wave, Q + ((size_t)bh * seqlen + qb * 256) * 96, K + (size_t)bh * seqlen * 96, V + (size_t)bh * seqlen * 64, O + ((size_t)b * seqlen + qb * 256) * 512 + h * 64, seqlen / 64, (char*)F.lds);
    }
}

constexpr int NPRE = 3, NMIX = 5, NFFN = 2, NSTEPS = NPRE + NL * (NGRP * NMIX - 1 + NFFN);
struct Args { const float* in[23]; float* out; unsigned char* ws; int s_lo, s_hi; };
__global__ void __launch_bounds__(NWAVES * 64, 2) mk_fwd(Args args) {
    extern __shared__ __attribute__((aligned(16))) unsigned char lds[];
    Frame F;
    F.lds = (LAS unsigned char*)lds;
    F.tid = threadIdx.x; F.lane = F.tid & 63; F.wave = __builtin_amdgcn_readfirstlane(F.tid >> 6);
    F.G = gridDim.x; { const int bx = blockIdx.x; F.vcu = (F.G % 8 == 0) ? (bx % 8) * (F.G / 8) + bx / 8 : bx; }
#pragma unroll
    for (int i = 0; i < 23; ++i) F.in[i] = args.in[i];
    F.out = args.out; F.ws = args.ws;
    unsigned* ctl = (unsigned*)(F.ws + WS_CTL);
    for (int u = F.tid; u < (LDS_BYTES - LDSCTL_OFF) / 4; u += NWAVES * 64) ((LAS unsigned*)(F.lds + LDSCTL_OFF))[u] = 0u;
    __syncthreads();
    const int s_lo = args.s_lo, s_hi = args.s_hi;
    XcdBarrier bar; bar.bar = ctl + CW_BAR; bar.x = 0; bar.st = nullptr;
    if (s_hi - s_lo > 1) bar = xcd_barrier_post(ctl + CW_BAR, (volatile LAS unsigned*)(F.lds + MISC_OFF) + 8);
    int step = 0;
#define RUN() (s_lo <= step && step < s_hi)
#define SEAM() do { if (step + 1 < s_hi) { xcd_barrier(bar); } } while (0)
    if (RUN()) { pre0(F); SEAM(); } ++step;
    if (RUN()) { pre1(F); SEAM(); } ++step;
    if (RUN()) { h0_init(F);
        pg8::Gemm g{(const bf16*)(F.ws + WS_SHA), (const bf16*)(F.ws + WS_WB), 256, 256, DM, DM, DM}; pg8::BiasOrder S{F.G, (int)blockIdx.x}; pg8::EpiBias E{(float*)(F.ws + WS_BIAS)};
        pg8::gemm_phase<DM, DM, DM, pg8::EpiBias, pg8::BiasOrder, true, true>(F.lds, g, S, E, F.wave); SEAM(); } ++step;
    for (int l = 0; l < NL; ++l) {
#define CTXL() int l_ = l; asm volatile("" : "+s"(l_)); Frame P = F; P.lane = lane_id_now(); P.tid = P.wave * 64 + P.lane; \
        const bf16* wb = (const bf16*)(F.ws + WS_WB + (size_t)l_ * WB_LAYER); const float* modl = (const float*)(F.ws + WS_MOD) + (size_t)l_ * NB * NMOD; \
        const float* biasl = (const float*)(F.ws + WS_BIAS) + (size_t)l_ * NB * (41 * 256); float* ssx = (float*)(F.ws + WS_SSX); bf16* HH = (bf16*)(F.ws + WS_HH); \
        const float* av1n = (const float*)(F.ws + WS_AV) + (size_t)(l_ + 1) * NB * DM; const float* av2 = (const float*)(F.ws + WS_AV) + (size_t)NL * NB * DM + (size_t)l_ * NB * DM; \
        (void)P; (void)wb; (void)modl; (void)biasl; (void)ssx; (void)HH; (void)av1n; (void)av2
        for (int grp = 0; grp < NGRP; ++grp) {
#define CTX() CTXL(); int g_ = grp; asm volatile("" : "+s"(g_)); \
            const int seqlen = g_ == 0 ? 8192 : 2048, nbatch = g_ == 0 ? 2 : 8, row_base = g_ * TG; \
            const float* xin32 = l_ == 0 ? (g_ == 0 ? F.in[0] : F.in[1]) : nullptr; bf16* x16g = (bf16*)(F.ws + WS_X16) + (size_t)g_ * TG * DM; \
            bf16* Hg = HH + (size_t)g_ * TG * DM; float* ssxg = ssx + (size_t)g_ * TG * 16; unsigned char* dsc = (unsigned char*)F.out; \
            bf16* LAT = (bf16*)(dsc + DO_LAT); bf16* U = (bf16*)(F.ws + WS_U); bf16* GV = (bf16*)(F.ws + WS_GV); bf16* SGA = (bf16*)(F.ws + WS_SGA); \
            bf16* SGB = (bf16*)(F.ws + WS_SGB); bf16* TMP = (bf16*)(F.ws + WS_TMP); \
            bf16* Qb = (bf16*)(dsc + DO_Q); bf16* Kb = (bf16*)(dsc + DO_K); bf16* Vb = (bf16*)(dsc + DO_V); bf16* Ob = (bf16*)(dsc + DO_O); float* ssl = (float*)(F.ws + WS_SSL); float* ssg = (float*)(F.ws + WS_SSG); \
            (void)seqlen; (void)nbatch; (void)row_base; (void)xin32; (void)x16g; (void)Hg; (void)ssxg; (void)LAT; (void)U; (void)GV; (void)SGA; (void)SGB; (void)TMP; (void)Qb; (void)Kb; (void)Vb; (void)Ob; (void)ssl; (void)ssg
            if (RUN()) { CTX(); pg8::Gemm g{Hg, wb + WO_IN, TG, NINP, DM, DM, DM}; pg8::StaticOrder S; S.init(TG, NINP, F.G, (int)blockIdx.x);
                LAS float* rtab = (LAS float*)(F.lds + RTAB_OFF); pg8::build_rstd_table(rtab, ssxg, S, P.tid);
                pg8::EpiProj E{LAT, U, GV, SGA, SGB, rtab, biasl, row_base, ssl, ssg};
                pg8::gemm_phase<DM, DM, DM, pg8::EpiProj, pg8::StaticOrder, true, true>(F.lds, g, S, E, F.wave); SEAM(); } ++step;
            if (RUN()) { CTX();
                { pg8::Gemm g{LAT, wb + WO_QB, TG, 1024, QLORA, LATW, QLORA}; pg8::StaticOrder S; S.init(TG, 1024, F.G, (int)blockIdx.x);
                  pg8::EpiQ E{Qb, ssl, F.in[12] + l_ * 96, (const float*)(F.ws + WS_ROPE), (const float*)(F.ws + WS_ROPE) + 8192 * 16, seqlen, att2::QSCALE};
                  pg8::gemm_phase<QLORA, LATW, QLORA, pg8::EpiQ, pg8::StaticOrder, true, true>(F.lds, g, S, E, F.wave); }
                { pg8::Gemm g{LAT + 512, wb + WO_KVB, TG, 1024, KVLORA, LATW, KVLORA}; pg8::StaticOrder S; S.init(TG, 1024, F.G, (int)blockIdx.x);
                  pg8::EpiKV E{Kb, Vb, LAT, LATW, ssl, F.in[13] + l_ * 96, (const float*)(F.ws + WS_ROPE), (const float*)(F.ws + WS_ROPE) + 8192 * 16, seqlen};
                  pg8::gemm_phase<KVLORA, LATW, KVLORA, pg8::EpiKV, pg8::StaticOrder, true, true>(F.lds, g, S, E, F.wave); }
                sgu_mix(P, GV, ssg, F.in[15] + l_ * DM, wb + WO_S, F.in[17] + l_ * 1024, U);
                SEAM(); } ++step;
            if (RUN()) { CTX(); attn_phase(P, Qb, Kb, Vb, Ob, nbatch, seqlen); SEAM(); } ++step;
            if (RUN()) { CTX();
                { pg8::Gemm g{Ob, wb + WO_OA, TG, DM, 512, 512, 512}; pg8::StaticOrder S; S.init(TG, DM, F.G, (int)blockIdx.x); pg8::EpiGate<false> E{SGA, nullptr, TMP, DM};
                  pg8::gemm_phase<512, 512, 512, pg8::EpiGate<false>, pg8::StaticOrder, true, true>(F.lds, g, S, E, F.wave); }
                { pg8::Gemm g{U, wb + WO_OB, TG, DM, DM, DM, DM}; pg8::StaticOrder S; S.init(TG, DM, F.G, (int)blockIdx.x); pg8::EpiGate<true> E{SGB, TMP, TMP, DM};
                  pg8::gemm_phase<DM, DM, DM, pg8::EpiGate<true>, pg8::StaticOrder, true, true>(F.lds, g, S, E, F.wave); }
                SEAM(); } ++step;
            if (RUN()) { CTX(); pg8::Gemm g{TMP, wb + WO_OUT, TG, DM, DM, DM, DM}; pg8::StaticOrder S; S.init(TG, DM, F.G, (int)blockIdx.x);
                pg8::EpiRes E{xin32, x16g, nullptr, x16g, modl + 2 * DM, NMOD, av2, Hg, ssxg, row_base};
                pg8::gemm_phase<DM, DM, DM, pg8::EpiRes, pg8::StaticOrder, true, true>(F.lds, g, S, E, F.wave);
                if (grp == NGRP - 1) SEAM(); }
            if (grp == NGRP - 1) ++step;
#undef CTX
        }
        if (RUN()) { CTXL(); pg8::Gemm g{HH, wb + WO_FI, TG2, 2 * DFF, DM, DM, DM}; pg8::StaticOrder S; S.init(TG2, 2 * DFF, F.G, (int)blockIdx.x);
            LAS float* rtab = (LAS float*)(F.lds + RTAB_OFF); pg8::build_rstd_table(rtab, ssx, S, P.tid);
            pg8::EpiSwiglu E{(bf16*)(F.ws + WS_ACT), DFF, rtab, biasl, 0};
            pg8::gemm_phase<DM, DM, DM, pg8::EpiSwiglu, pg8::StaticOrder, true, true>(F.lds, g, S, E, F.wave); SEAM(); } ++step;
        if (RUN()) { CTXL(); pg8::Gemm g{(const bf16*)(F.ws + WS_ACT), wb + WO_FO, TG2, DM, DFF, DFF, DFF}; pg8::StaticOrder S; S.init(TG2, DM, F.G, (int)blockIdx.x);
            bf16* x16 = (bf16*)(F.ws + WS_X16);
            pg8::EpiRes E{nullptr, x16, l_ + 1 < NL ? nullptr : F.out, x16, modl + 5 * DM, NMOD, av1n, l_ + 1 < NL ? HH : nullptr, ssx, 0};
            pg8::gemm_phase<DFF, DFF, DFF, pg8::EpiRes, pg8::StaticOrder, false, true>(F.lds, g, S, E, F.wave); SEAM(); } ++step;
#undef CTXL
    }
#undef RUN
#undef SEAM
}

extern "C" void kernel_launch(void* const* d_in, const int* in_sizes, int n_in, void* d_out, int out_size, void* d_ws, size_t ws_size, hipStream_t stream) {
    static int grid = 0;
    if (grid == 0) {
        if (n_in != 23 || out_size != NGRP * TG * DM || ws_size < WS_END) { fprintf(stderr, "kernel_launch: unexpected shapes (n_in %d, out %d, ws %zu; need ws >= %zu); nothing launched\n", n_in, out_size, ws_size, (size_t)WS_END); grid = -1; return; }
        int dev = 0, cus = 0, per_cu = 0;
        if (hipGetDevice(&dev) != hipSuccess || hipDeviceGetAttribute(&cus, hipDeviceAttributeMultiprocessorCount, dev) != hipSuccess) { grid = -1; return; }
        if (hipFuncSetAttribute((const void*)mk_fwd, hipFuncAttributeMaxDynamicSharedMemorySize, LDS_BYTES) != hipSuccess) { fprintf(stderr, "kernel_launch: hipFuncSetAttribute failed\n"); grid = -1; return; }
        if (hipOccupancyMaxActiveBlocksPerMultiprocessor(&per_cu, (const void*)mk_fwd, NWAVES * 64, LDS_BYTES) != hipSuccess || per_cu < 1) { fprintf(stderr, "kernel_launch: occupancy query reports %d\n", per_cu); }
        (void)hipGetLastError();
        if (cus < 256) { fprintf(stderr, "kernel_launch: built for a 256-CU device (the fused q / kv epilogues need one 256 x 256 unit per workgroup), found %d CUs; nothing launched\n", cus); grid = -1; return; }
        grid = 256;
    }
    if (grid < 0) return;
    if (hipMemsetAsync((char*)d_ws + WS_CTL, 0, CTL_ZERO_BYTES, stream) != hipSuccess) return;
    Args a{};
    for (int i = 0; i < 23; ++i) a.in[i] = (const float*)d_in[i];
    a.out = (float*)d_out; a.ws = (unsigned char*)d_ws;
#if MK_ONE_LAUNCH
    a.s_lo = 0; a.s_hi = NSTEPS;
    hipLaunchKernelGGL(mk_fwd, dim3(grid), dim3(NWAVES * 64), LDS_BYTES, stream, a);
#else
    for (int s = 0; s < NSTEPS; ++s) { a.s_lo = s; a.s_hi = s + 1; hipLaunchKernelGGL(mk_fwd, dim3(grid), dim3(NWAVES * 64), LDS_BYTES, stream, a); }
#endif
    const hipError_t le = hipPeekAtLastError();
    if (le != hipSuccess) fprintf(stderr, "kernel_launch: launch failed: %s\n", hipGetErrorName(le));
}
```
